# Optimizing an MI355X kernel written in HIP

```python
import math
import jax, jax.numpy as jnp
from jax import lax
import numpy as np

D_MODEL = 1024
BATCH = 2
SEQ = 8192
DEPTH = 1
DEC_BATCH = 32
DEC_SEQ = 4
PAST_LEN = 16384
PAGE_SIZE = 128

RET_HEADS = 4
RET_DK = 128
RET_DV = 256
RET_CHUNK = 128
ROPE_BASE = 10000.0
ATT_GROUPS = ((128, 1), (512, 4), (2048, 16))
N_GROUPS = 3
ATT_HEADS = 8
ATT_DH = 64
Q_BLOCK = 128
REL_BUCKETS = 32
REL_MAX_DIST = 2048
EPS = 1e-6

RET_QK_W = RET_HEADS * RET_DK
RET_V_W = RET_HEADS * RET_DV
ATT_W = N_GROUPS * ATT_HEADS * ATT_DH
ATT_OUT_W = ATT_HEADS * ATT_DH
IN_SPLITS = (RET_QK_W, RET_QK_W, RET_V_W, RET_V_W, ATT_W, ATT_W, ATT_W, ATT_OUT_W, D_MODEL, D_MODEL)
IN_W = 2 * RET_QK_W + 2 * RET_V_W + 3 * ATT_W + ATT_OUT_W + 2 * D_MODEL

kernel_name = 'retention_dilated_attn_hybrid_step'


def rms_norm(x, g):
    x32 = x.astype(jnp.float32)
    y = x32 * lax.rsqrt(jnp.mean(x32 * x32, axis=-1, keepdims=True) + EPS)
    return (y * g.astype(jnp.float32)).astype(x.dtype)


def head_rms(x, g):
    x32 = x.astype(jnp.float32)
    y = x32 * lax.rsqrt(jnp.mean(x32 * x32, axis=-1, keepdims=True) + EPS)
    return (y * g.astype(jnp.float32)).astype(x.dtype)


def head_group_norm(o, g):
    mu = jnp.mean(o, axis=-1, keepdims=True)
    var = jnp.mean(jnp.square(o - mu), axis=-1, keepdims=True)
    return (o - mu) * lax.rsqrt(var + EPS) * g.astype(jnp.float32).reshape(RET_HEADS, RET_DV)


def split_cols(p):
    out, s = [], 0
    for w in IN_SPLITS:
        out.append(p[..., s:s + w])
        s += w
    return out


def rotary(x, pos):
    half = x.shape[-1] // 2
    inv = ROPE_BASE ** (-jnp.arange(half, dtype=jnp.float32) / half)
    ang = pos[:, None] * inv[None, :]
    cos = jnp.cos(ang)[None, :, None, :]
    sin = jnp.sin(ang)[None, :, None, :]
    x32 = x.astype(jnp.float32)
    x1, x2 = x32[..., :half], x32[..., half:]
    return jnp.concatenate([x1 * cos - x2 * sin, x1 * sin + x2 * cos], axis=-1).astype(x.dtype)


def retention_scan(q, k, v, state0):
    B, T, H, _ = q.shape
    C = RET_CHUNK if T % RET_CHUNK == 0 else T
    n = T // C
    log_g = jnp.log1p(-(2.0 ** (-5.0 - jnp.arange(H, dtype=jnp.float32))))
    i = jnp.arange(C, dtype=jnp.float32)
    diff = i[:, None] - i[None, :]
    decay = jnp.where(diff[None] >= 0, jnp.exp(jnp.maximum(diff, 0.0)[None] * log_g[:, None, None]), 0.0)
    q_decay = jnp.exp((i + 1.0)[:, None] * log_g[None, :])
    k_decay = jnp.exp((C - 1.0 - i)[:, None] * log_g[None, :])
    chunk_decay = jnp.exp(C * log_g)

    def step(S, qkv):
        qc, kc, vc = qkv
        scores = jnp.einsum('bqhd,bkhd->bhqk', qc, kc) * decay[None]
        o = (jnp.einsum('bhqk,bkhe->bqhe', scores, vc)
             + jnp.einsum('bqhd,bhde->bqhe', qc, S) * q_decay[None, :, :, None])
        S = S * chunk_decay[None, :, None, None] + jnp.einsum('bkhd,bkhe->bhde', kc * k_decay[None, :, :, None], vc)
        return S, o

    xs = tuple(a.astype(jnp.float32).reshape(B, n, C, H, a.shape[-1]).transpose(1, 0, 2, 3, 4) for a in (q, k, v))
    S, o = lax.scan(step, state0.astype(jnp.float32), xs)
    o = o.transpose(1, 0, 2, 3, 4).reshape(B, T, H, RET_DV)
    return o, S


def t5_bucket(dist):
    max_exact = REL_BUCKETS // 2
    d = jnp.maximum(dist.astype(jnp.float32), 1.0)
    large = max_exact + (jnp.log(d / max_exact) / math.log(REL_MAX_DIST / max_exact)
                         * (REL_BUCKETS - max_exact)).astype(jnp.int32)
    large = jnp.minimum(large, REL_BUCKETS - 1)
    return jnp.where(dist < max_exact, dist, large)


def group_bias(rel_bias, g, win, dil):
    dist = dil * jnp.arange(win // dil + 1, dtype=jnp.int32)
    b = rel_bias[t5_bucket(dist)][:, g * ATT_HEADS:(g + 1) * ATT_HEADS]
    return b.astype(jnp.float32).T


def dilated_group(q, kv_ext, start, dil, bias):
    tq = q.shape[1]
    M = bias.shape[1]
    idx = start + jnp.arange(tq)[:, None] - dil * jnp.arange(M)[None, :]
    valid = idx >= 0
    kv = jnp.take(kv_ext, jnp.maximum(idx, 0), axis=1)
    logits = jnp.einsum('bqhd,bqmhd->bhqm', q, kv[:, :, :, 0]).astype(jnp.float32) + bias[None, :, None, :]
    logits = jnp.where(valid[None, None], logits, -jnp.inf)
    lse = jax.nn.logsumexp(logits, axis=-1)
    p = jnp.exp(logits - lse[..., None]).astype(kv.dtype)
    o = jnp.einsum('bhqm,bqmhd->bqhd', p, kv[:, :, :, 1])
    return o, lse.transpose(0, 2, 1)


def dilated_attention(q, kv_exts, buf_lens, rel_bias):
    B, T = q.shape[:2]
    biases = [group_bias(rel_bias, g, w, d) for g, (w, d) in enumerate(ATT_GROUPS)]

    def attend(q_blk, t0):
        outs, lses = [], []
        for g, (win, dil) in enumerate(ATT_GROUPS):
            o, lse = dilated_group(q_blk[:, :, g], kv_exts[g], buf_lens[g] + t0, dil, biases[g])
            outs.append(o)
            lses.append(lse)
        w = jax.nn.softmax(jnp.stack(lses, axis=2), axis=2)
        o = jnp.einsum('bqgh,bqghd->bqhd', w, jnp.stack(outs, axis=2).astype(jnp.float32))
        return o.astype(q_blk.dtype)

    if T > Q_BLOCK and T % Q_BLOCK == 0:
        nb = T // Q_BLOCK
        qb = q.reshape(B, nb, Q_BLOCK, N_GROUPS, ATT_HEADS, ATT_DH).transpose(1, 0, 2, 3, 4, 5)
        out = lax.map(lambda a: attend(a[0], a[1]), (qb, jnp.arange(nb, dtype=jnp.int32) * Q_BLOCK))
        return out.transpose(1, 0, 2, 3, 4).reshape(B, T, ATT_HEADS, ATT_DH)
    return attend(q, 0)


def mixer_layer(x, pos0, ret_state0, kv_bufs, rel_bias, w_norm, w_in, q_norm, k_norm,
                ret_norm, w_proj_ret, w_proj_att, w_out):
    B, T, _ = x.shape
    h = rms_norm(x, w_norm)
    rq, rk, rv, rg, aq, ak, av, ag, ga, gb = split_cols(h @ w_in)
    pos = pos0 + jnp.arange(T, dtype=jnp.float32)
    rq = rotary(rq.reshape(B, T, RET_HEADS, RET_DK), pos)
    rk = rotary(rk.reshape(B, T, RET_HEADS, RET_DK), pos) * (RET_DK ** -0.5)
    rv = rv.reshape(B, T, RET_HEADS, RET_DV)
    ret_o, ret_state = retention_scan(rq, rk, rv, ret_state0)
    ret_o = head_group_norm(ret_o, ret_norm).reshape(B, T, RET_V_W).astype(x.dtype)
    o_a = (jax.nn.silu(rg) * ret_o) @ w_proj_ret
    aq = head_rms(aq.reshape(B, T, N_GROUPS, ATT_HEADS, ATT_DH), q_norm) * (ATT_DH ** -0.5)
    ak = head_rms(ak.reshape(B, T, N_GROUPS, ATT_HEADS, ATT_DH), k_norm)
    av = av.reshape(B, T, N_GROUPS, ATT_HEADS, ATT_DH)
    kv_new = jnp.stack([ak, av], axis=3)
    kv_exts, buf_lens, kv_rows = [], [], []
    for g, (win, dil) in enumerate(ATT_GROUPS):
        new_g = kv_new[:, :, g]
        if kv_bufs is None:
            kv_exts.append(new_g)
            buf_lens.append(0)
            kv_rows.append(new_g[:, T - min(win, T):])
        else:
            buf = kv_bufs[g].astype(new_g.dtype)
            kv_exts.append(jnp.concatenate([buf, new_g], axis=1))
            buf_lens.append(buf.shape[1])
            kv_rows.append(new_g)
    att_o = dilated_attention(aq, kv_exts, buf_lens, rel_bias).reshape(B, T, ATT_OUT_W)
    o_b = (jax.nn.silu(ag) * att_o) @ w_proj_att
    merged = jax.nn.sigmoid(ga) * o_a + jax.nn.sigmoid(gb) * o_b
    return x + merged @ w_out, ret_state, kv_rows


def setup_inputs(seed: int = 0) -> dict:
    key = jax.random.key(seed)
    ks = jax.random.split(key, 16)
    f32 = jnp.float32
    nrm = lambda k, s: jax.random.normal(k, s, f32)
    caches = [nrm(ks[2 + g], (DEPTH, DEC_BATCH, min(w, PAST_LEN), 2, ATT_HEADS, ATT_DH))
              for g, (w, d) in enumerate(ATT_GROUPS)]
    return {
        'x_prompt': nrm(ks[0], (BATCH, SEQ, D_MODEL)),
        'x_sample': nrm(ks[1], (DEC_BATCH, DEC_SEQ, D_MODEL)),
        'cache_kv_w128': caches[0],
        'cache_kv_w512': caches[1],
        'cache_kv_w2048': caches[2],
        'state_retention': 0.5 * nrm(ks[5], (DEPTH, DEC_BATCH, RET_HEADS, RET_DK, RET_DV)),
        'w_norm': 1.0 + 0.02 * nrm(ks[6], (DEPTH, D_MODEL)),
        'w_in': nrm(ks[7], (DEPTH, D_MODEL, IN_W)) * D_MODEL ** -0.5,
        'q_norm': 1.0 + 0.02 * nrm(ks[8], (DEPTH, ATT_DH)),
        'k_norm': 1.0 + 0.02 * nrm(ks[9], (DEPTH, ATT_DH)),
        'rel_bias': 0.5 * nrm(ks[10], (REL_BUCKETS, N_GROUPS * ATT_HEADS)),
        'ret_norm': 1.0 + 0.02 * nrm(ks[11], (DEPTH, RET_V_W)),
        'w_proj_ret': nrm(ks[12], (DEPTH, RET_V_W, D_MODEL)) * RET_V_W ** -0.5,
        'w_proj_att': nrm(ks[13], (DEPTH, ATT_OUT_W, D_MODEL)) * ATT_OUT_W ** -0.5,
        'w_out': nrm(ks[14], (DEPTH, D_MODEL, D_MODEL)) * D_MODEL ** -0.5,
    }


def reference(x_prompt, x_sample, cache_kv_w128, cache_kv_w512, cache_kv_w2048, state_retention,
              w_norm, w_in, q_norm, k_norm, rel_bias, ret_norm, w_proj_ret, w_proj_att, w_out):
    y_p, y_s = x_prompt, x_sample
    rs_p, rs_s = [], []
    kvp = [[], [], []]
    kvs = [[], [], []]
    for l in range(DEPTH):
        lw = (w_norm[l], w_in[l], q_norm[l], k_norm[l], ret_norm[l], w_proj_ret[l], w_proj_att[l], w_out[l])
        zero_state = jnp.zeros((x_prompt.shape[0], RET_HEADS, RET_DK, RET_DV), jnp.float32)
        y_p, st_p, rows_p = mixer_layer(y_p, 0, zero_state, None, rel_bias, *lw)
        bufs = (cache_kv_w128[l], cache_kv_w512[l], cache_kv_w2048[l])
        y_s, st_s, rows_s = mixer_layer(y_s, PAST_LEN, state_retention[l], bufs, rel_bias, *lw)
        rs_p.append(st_p)
        rs_s.append(st_s)
        for g in range(N_GROUPS):
            kvp[g].append(rows_p[g])
            kvs[g].append(rows_s[g])
    ret_state_prompt = jnp.stack(rs_p)
    ret_state_sample = jnp.stack(rs_s)
    kv_w128_prompt = jnp.stack(kvp[0])
    kv_w512_prompt = jnp.stack(kvp[1])
    kv_w2048_prompt = jnp.stack(kvp[2])
    kv_w128_sample = jnp.stack(kvs[0])
    kv_w512_sample = jnp.stack(kvs[1])
    kv_w2048_sample = jnp.stack(kvs[2])
    return (y_p, y_s, ret_state_prompt, ret_state_sample, kv_w128_prompt, kv_w512_prompt, kv_w2048_prompt, kv_w128_sample, kv_w512_sample, kv_w2048_sample)
```

```cpp
#include <hip/hip_runtime.h>
#include <cstdio>
#include <cstdint>
#include <cmath>
constexpr int NWAVES = 8;
constexpr int DM = 1024, NB = 2, TP = 8192, MP = NB * TP;
constexpr int SB = 32, ST = 4, MS = SB * ST;
constexpr int MR = MP + MS, MPAD = 16640;
constexpr int INW = 10240;
constexpr int C_RQ = 0, C_RK = 512, C_RV = 1024, C_RG = 2048, C_AQ = 3072, C_AK = 4608, C_AV = 6144, C_AG = 7680, C_GA = 8192, C_GB = 9216;
constexpr int GATE_OFF = C_GA * 2;
constexpr int NCH = TP / 128;
constexpr float EPSF = 1e-6f;
constexpr size_t O_YP = 0, O_YS = O_YP + (size_t)MP * DM, O_RSP = O_YS + (size_t)MS * DM, O_RSS = O_RSP + (size_t)NB * 4 * 128 * 256,
                 O_KVP0 = O_RSS + (size_t)SB * 4 * 128 * 256, O_KVP1 = O_KVP0 + (size_t)NB * 128 * 1024, O_KVP2 = O_KVP1 + (size_t)NB * 512 * 1024,
                 O_KVS0 = O_KVP2 + (size_t)NB * 2048 * 1024, O_KVS1 = O_KVS0 + (size_t)MS * 1024, O_KVS2 = O_KVS1 + (size_t)MS * 1024, O_END = O_KVS2 + (size_t)MS * 1024;
constexpr size_t MiB = 1u << 20;
constexpr size_t WS_CTL = 0, CTL_ZERO_BYTES = 131072;
constexpr size_t WS_TB = 1 * MiB;
constexpr int TB_STRIDE = 136, TB_C = 4000;
constexpr int TBL_STRIDE = 176, TBG_OFF = 8192;
constexpr size_t WS_ROPE = 2 * MiB;
constexpr size_t WS_WIN = 8 * MiB, WS_WPR = 28 * MiB, WS_WPA = 30 * MiB, WS_WOUT = 31 * MiB;
constexpr size_t WS_XB = 34 * MiB;
constexpr size_t WS_P = 68 * MiB;
constexpr size_t WS_KV = 394 * MiB;
constexpr size_t WS_SC = 458 * MiB;
constexpr size_t WS_GA = 490 * MiB;
constexpr size_t WS_GB = 523 * MiB;
constexpr size_t WS_MG = 540 * MiB;
constexpr size_t WS_OG = 573 * MiB;
constexpr size_t WS_L = 669 * MiB;
constexpr size_t WS_OGS = 671 * MiB;
constexpr size_t WS_LS = WS_OGS + 768 * 1024;
constexpr size_t WS_APL = 672 * MiB;
constexpr size_t WS_END = 820 * MiB;
constexpr int CW_TMO = 0, CW_CODE = 1, CW_BAR = 4096;
constexpr int LDS_BYTES = 147456;
constexpr int LDSCTL_OFF = 146944, MISC_OFF = LDSCTL_OFF + 320;
constexpr int RING_OFF = 0;
constexpr int GAINS_OFF = 146432;

__host__ __device__ __forceinline__ int apl_row(int r, int lg) { return (r < MP) ? ((r & ~(TP - 1)) | ((r & ((1 << lg) - 1)) << (13 - lg)) | ((r & (TP - 1)) >> lg)) : r; }
#define GAS __attribute__((address_space(1)))
#define LAS __attribute__((address_space(3)))
typedef unsigned short bf16;
typedef unsigned v4u __attribute__((ext_vector_type(4)));
typedef unsigned v2u __attribute__((ext_vector_type(2)));
typedef float f32x4 __attribute__((ext_vector_type(4)));
typedef float f32x2 __attribute__((ext_vector_type(2)));
typedef short bf16x8 __attribute__((ext_vector_type(8)));
typedef short s16x4 __attribute__((ext_vector_type(4)));
typedef GAS unsigned gu32;
#define RLX_AGENT __ATOMIC_RELAXED, __HIP_MEMORY_SCOPE_AGENT
#define LDS_WAIT() asm volatile("s_waitcnt lgkmcnt(0)" ::: "memory")
#define VM_WAIT() asm volatile("s_waitcnt vmcnt(0)" ::: "memory")
__device__ __forceinline__ unsigned f2bf(float f) { unsigned u = __builtin_bit_cast(unsigned, f); return (u + 0x7fffu + ((u >> 16) & 1u)) >> 16; }
typedef __bf16 bf16x2_t __attribute__((ext_vector_type(2)));
__device__ __forceinline__ unsigned pk2(float lo, float hi) { f32x2 v = {lo, hi}; bf16x2_t b = __builtin_convertvector(v, bf16x2_t); return __builtin_bit_cast(unsigned, b); }
__device__ __forceinline__ float bf2f(unsigned short h) { return __uint_as_float((unsigned)h << 16); }
__device__ __forceinline__ float bflo(unsigned w) { return __uint_as_float(w << 16); }
__device__ __forceinline__ float bfhi(unsigned w) { return __uint_as_float(w & 0xffff0000u); }
__device__ __forceinline__ float fexp2(float x) { return __builtin_amdgcn_exp2f(x); }
__device__ __forceinline__ float frcp(float x) { return __builtin_amdgcn_rcpf(x); }
__device__ __forceinline__ float frsq(float x) { return __builtin_amdgcn_rsqf(x); }
__device__ __forceinline__ float silu_f(float x) { return x * frcp(1.0f + fexp2(-1.4426950408889634f * x)); }
#define MFMA16(a, b, c) __builtin_amdgcn_mfma_f32_16x16x32_bf16((a), (b), (c), 0, 0, 0)
typedef short v4i16_t __attribute__((ext_vector_type(4)));
__device__ __forceinline__ s16x4 vtr(const LAS unsigned char* p) { return __builtin_bit_cast(s16x4, __builtin_amdgcn_ds_read_tr16_b64_v4i16((LAS v4i16_t*)p)); }
__device__ __forceinline__ bf16x8 cat8(s16x4 a, s16x4 b) { return (bf16x8){a[0], a[1], a[2], a[3], b[0], b[1], b[2], b[3]}; }
__device__ __forceinline__ bf16x8 pack8(float a0, float a1, float a2, float a3, float a4, float a5, float a6, float a7) {
    v4u w; w.x = pk2(a0, a1); w.y = pk2(a2, a3); w.z = pk2(a4, a5); w.w = pk2(a6, a7); return __builtin_bit_cast(bf16x8, w); }
__device__ __forceinline__ float wave_sum(float v) {
#pragma unroll
    for (int o = 1; o < 64; o <<= 1) v += __shfl_xor(v, o);
    return v;
}
namespace pg8 {
#define PG8_LAS __attribute__((address_space(3)))
typedef unsigned short bf16_t;
typedef short bf16x8 __attribute__((ext_vector_type(8)));
typedef float f32x4 __attribute__((ext_vector_type(4)));
typedef unsigned u32x4 __attribute__((ext_vector_type(4)));
typedef unsigned u32x2 __attribute__((ext_vector_type(2)));
constexpr int BM = 256, BK = 64, HALF = 128, HTB = HALF * BK * 2  , STAGE_BYTES = 8 * HTB, NXCD = 8, WGM = 8;

__host__ __device__ __forceinline__ int lds_byte(int r, int c) { const int st = (r >> 4) * 2 + (c >> 5), rr = r & 15, cc = c & 31, ob = rr * 64 + cc * 2; return st * 1024 + (ob ^ (((ob >> 9) & 1) << 5)); }
__host__ __device__ __forceinline__ void stage_rc(int b, int& R, int& C) { const int st = b / 1024, sb = b % 1024, swz = sb ^ (((sb >> 9) & 1) << 5); R = (st >> 1) * 16 + swz / 64; C = (st & 1) * 32 + (swz % 64) / 2; }
__host__ __device__ __forceinline__ int perm32(int rho) { const int n = rho >> 4, i = rho & 15; return 8 * (i >> 2) + 4 * n + (i & 3); }

struct Unit { int pm, pn; };
struct Gemm { const bf16_t* A; const bf16_t* Bt; int M, N, K; };

struct StaticOrder {
    int nM, nN, nwg, G, c, rot;
    __host__ __device__ __forceinline__ void init(int M, int N, int G_, int c_, int rot_ = 0) { nM = M / BM; nN = N / BM; nwg = nM * nN; G = G_; c = c_; rot = rot_; }
    __host__ __device__ __forceinline__ bool next(int i, Unit& u) const {
        const long L = (long)i * G + c; if (L >= nwg) return false;
        int wgid = (int)L; { const int q = nwg / NXCD, r = nwg % NXCD, xcd = wgid % NXCD, off = wgid / NXCD; wgid = (xcd < r ? xcd * (q + 1) : r * (q + 1) + (xcd - r) * q) + off; }
        const int nig = WGM * nN, gid = wgid / nig, fm = gid * WGM, gsz = (nM - fm) < WGM ? (nM - fm) : WGM;
        u.pm = fm + ((wgid % nig) % gsz); const int j = (wgid % nig) / gsz;
        if (rot >= 0) { u.pn = j + rot; if (u.pn >= nN) u.pn -= nN; }
        else u.pn = (j < 8) ? 32 + j : (j < 32) ? j : j - 32;
        return true;
    }
    __device__ __forceinline__ void a_ready(const Unit&) const {}
    __device__ __forceinline__ void done(const Unit&) const {}
};
struct RangeOrder {
    StaticOrder S; int i0, n;
    __host__ __device__ __forceinline__ bool next(int i, Unit& u) const { return i < n && S.next(i0 + i, u); }
    __device__ __forceinline__ void a_ready(const Unit&) const {}
    __device__ __forceinline__ void done(const Unit&) const {}
};

__device__ __forceinline__ unsigned cvt_pk_bf16(float lo, float hi) { unsigned r; asm volatile("v_cvt_pk_bf16_f32 %0, %1, %2" : "=v"(r) : "v"(lo), "v"(hi)); return r; }
typedef float f32x2 __attribute__((ext_vector_type(2)));
template <class Epi, class Sched, bool ALIGN_EPI = false, bool SP2 = false, bool PRE = false, bool LAUNDER = false>
__device__ __forceinline__ void gemm_phase(PG8_LAS unsigned char* lds, const Gemm g, const Sched& S, const Epi& E, f32x4 (*acc0)[2][4][2] = nullptr) {
    int tid_ = threadIdx.x; if constexpr (LAUNDER) asm volatile("" : "+v"(tid_));
    const int tid = tid_, wid = __builtin_amdgcn_readfirstlane(tid >> 6), lane = tid & 63, wr = wid >> 2, wc = wid & 3, fr = lane & 15, fq = lane >> 4;
    const int K = g.K, nt = K / BK;
    unsigned voffA[2], voffB[2];
#pragma unroll
    for (int i = 0; i < 2; ++i) { int R, C; stage_rc(tid * 16 + i * 8192, R, C); const int Rb = Epi::PERM ? ((R & ~31) + perm32(R & 31)) : R;
        voffA[i] = (unsigned)(R * K + C) * 2u; voffB[i] = (unsigned)(Rb * K + C) * 2u; }
    const size_t kstep = (size_t)(BK * 2);
    const size_t hstep = (size_t)HALF * K * 2;
    const size_t tstep = 2 * hstep;
    const unsigned ldsw = (unsigned)wid * 1024u;
    const int aoff = lds_byte(wr * 64 + fr, fq * 8), boff = lds_byte(wc * 32 + fr, fq * 8);
#define PG8_SA(b, h) (((b) * 2 + (h)) * HTB)
#define PG8_SB(b, h) ((4 + (b) * 2 + (h)) * HTB)
#define PG8_STAGE(bufoff, gbase, voff) do { _Pragma("unroll") for (int _i = 0; _i < 2; ++_i) \
        __builtin_amdgcn_global_load_lds((const unsigned*)((const char*)(gbase) + (voff)[_i]), (PG8_LAS unsigned*)(lds + (bufoff) + ldsw + _i * 8192), 16, 0, 0); } while (0)
#define PG8_LDA(dst, b, h) do { _Pragma("unroll") for (int m = 0; m < 4; ++m) _Pragma("unroll") for (int k = 0; k < 2; ++k) dst[m][k] = *(const PG8_LAS bf16x8*)(lds + PG8_SA(b, h) + aoff + m * 2048 + k * 1024); } while (0)
#define PG8_LDB(dst, b, h) do { _Pragma("unroll") for (int n = 0; n < 2; ++n) _Pragma("unroll") for (int k = 0; k < 2; ++k) dst[n][k] = *(const PG8_LAS bf16x8*)(lds + PG8_SB(b, h) + boff + n * 2048 + k * 1024); } while (0)
#define PG8_MMA(ai, bj, At, Bt) do { __builtin_amdgcn_s_setprio(1); _Pragma("unroll") for (int m = 0; m < 4; ++m) _Pragma("unroll") for (int n = 0; n < 2; ++n) _Pragma("unroll") for (int k = 0; k < 2; ++k) \
        acc[ai][bj][m][n] = __builtin_amdgcn_mfma_f32_16x16x32_bf16(Bt[n][k], At[m][k], acc[ai][bj][m][n], 0, 0, 0); __builtin_amdgcn_s_setprio(0); } while (0)
#define PG8_WAIT_V(n) asm volatile("s_waitcnt vmcnt(" #n ")" ::: "memory")
#define PG8_WAIT_L(n) asm volatile("s_waitcnt lgkmcnt(" #n ")" ::: "memory")
#define PG8_BAR __builtin_amdgcn_s_barrier()
#define PG8_SCHED __builtin_amdgcn_sched_barrier(0)
    Unit cur, nxt; int ui = 0;
    if (!S.next(0, cur)) return;
    f32x4 acc[2][2][4][2];
    if constexpr (PRE) {
#pragma unroll
        for (int a = 0; a < 2; ++a)
#pragma unroll
            for (int b = 0; b < 2; ++b)
#pragma unroll
                for (int m = 0; m < 4; ++m)
#pragma unroll
                    for (int n = 0; n < 2; ++n) acc[a][b][m][n] = acc0[a][b][m][n];
    } else if constexpr (Epi::HAS_INIT) E.init(acc, cur, wr, wc, fr, fq);
    else {
#pragma unroll
    for (int a = 0; a < 2; ++a)
#pragma unroll
        for (int b = 0; b < 2; ++b)
#pragma unroll
            for (int m = 0; m < 4; ++m)
#pragma unroll
                for (int n = 0; n < 2; ++n) acc[a][b][m][n] = (f32x4){0.f, 0.f, 0.f, 0.f};
    }
    bf16x8 At[4][2], B0[2][2], B1[2][2];
    const char* cA = (const char*)g.A + (size_t)cur.pm * tstep; const char* cB = (const char*)g.Bt + (size_t)cur.pn * tstep;
    S.a_ready(cur);
    if constexpr (SP2) {
        PG8_STAGE(PG8_SB(0, 0), cB, voffB); PG8_STAGE(PG8_SB(0, 1), cB + hstep, voffB); PG8_STAGE(PG8_SA(0, 0), cA, voffA); PG8_STAGE(PG8_SA(0, 1), cA + hstep, voffA);
        if (wr == 1) PG8_BAR;
        PG8_WAIT_V(2); PG8_BAR;
        PG8_STAGE(PG8_SB(1, 0), cB + kstep, voffB); PG8_STAGE(PG8_SA(1, 0), cA + kstep, voffA); PG8_STAGE(PG8_SB(1, 1), cB + hstep + kstep, voffB);
        PG8_WAIT_V(6); PG8_BAR;
    } else {
        PG8_STAGE(PG8_SB(0, 0), cB, voffB); PG8_STAGE(PG8_SA(0, 0), cA, voffA); PG8_STAGE(PG8_SB(0, 1), cB + hstep, voffB); PG8_STAGE(PG8_SA(0, 1), cA + hstep, voffA);
        if (wr == 1) PG8_BAR;
        PG8_WAIT_V(4); PG8_BAR;
        PG8_STAGE(PG8_SB(1, 0), cB + kstep, voffB); PG8_STAGE(PG8_SA(1, 0), cA + kstep, voffA); PG8_STAGE(PG8_SB(1, 1), cB + hstep + kstep, voffB);
        PG8_WAIT_V(6); PG8_BAR;
    }
    for (;;) {
        const bool has_next = S.next(ui + 1, nxt);
        const char* nA = has_next ? (const char*)g.A + (size_t)nxt.pm * tstep : cA; const char* nB = has_next ? (const char*)g.Bt + (size_t)nxt.pn * tstep : cB;
        for (int t = 0; t < nt; t += 2) {
            if constexpr (Epi::MIDK > 0) { if (t == Epi::MIDK) { int z_ = 0; asm volatile("" : "+v"(z_)); E.mid(acc, cur, wr, wc, fr + z_, fq, -1); } }
            const bool last = (t == nt - 2);
            const char* a1 = cA + (size_t)(t + 1) * kstep;
            const char* a2 = last ? nA : cA + (size_t)(t + 2) * kstep; const char* b2 = last ? nB : cB + (size_t)(t + 2) * kstep;
            const char* a3 = a2 + kstep; const char* b3 = b2 + kstep;
            if (last && has_next) S.a_ready(nxt);
            if constexpr (SP2) {
            PG8_LDB(B0, 0, 0); PG8_LDB(B1, 0, 1); PG8_SCHED; PG8_LDA(At, 0, 0); PG8_STAGE(PG8_SA(1, 1), a1 + hstep, voffA);
            PG8_WAIT_V(8); PG8_WAIT_L(0); PG8_BAR; PG8_MMA(0, 0, At, B0); PG8_MMA(0, 1, At, B1); PG8_BAR; PG8_SCHED;
            PG8_LDA(At, 0, 1); PG8_STAGE(PG8_SB(0, 0), b2, voffB); PG8_STAGE(PG8_SB(0, 1), b2 + hstep, voffB); PG8_STAGE(PG8_SA(0, 0), a2, voffA);
            PG8_WAIT_V(8); PG8_WAIT_L(0); PG8_BAR; PG8_MMA(1, 0, At, B0); PG8_MMA(1, 1, At, B1); PG8_BAR; PG8_SCHED;
            PG8_LDB(B0, 1, 0); PG8_LDB(B1, 1, 1); PG8_SCHED; PG8_LDA(At, 1, 0); PG8_STAGE(PG8_SA(0, 1), a2 + hstep, voffA);
            PG8_WAIT_V(8); PG8_WAIT_L(0); PG8_BAR; PG8_MMA(0, 0, At, B0); PG8_MMA(0, 1, At, B1); PG8_BAR; PG8_SCHED;
            PG8_LDA(At, 1, 1); PG8_STAGE(PG8_SB(1, 0), b3, voffB); PG8_STAGE(PG8_SB(1, 1), b3 + hstep, voffB); PG8_STAGE(PG8_SA(1, 0), a3, voffA);
            PG8_WAIT_V(8); PG8_WAIT_L(0); PG8_BAR; PG8_MMA(1, 0, At, B0); PG8_MMA(1, 1, At, B1); PG8_BAR; PG8_SCHED;
            } else {
            PG8_LDB(B0, 0, 0); PG8_SCHED; PG8_LDA(At, 0, 0); PG8_STAGE(PG8_SA(1, 1), a1 + hstep, voffA);
            PG8_WAIT_L(8); PG8_BAR; PG8_WAIT_L(0); PG8_MMA(0, 0, At, B0); PG8_BAR; PG8_SCHED;
            PG8_LDB(B1, 0, 1); PG8_STAGE(PG8_SB(0, 0), b2, voffB);
            PG8_BAR; PG8_WAIT_L(0); PG8_MMA(0, 1, At, B1); PG8_BAR;
            PG8_LDA(At, 0, 1); PG8_STAGE(PG8_SA(0, 0), a2, voffA);
            PG8_BAR; PG8_WAIT_L(0); PG8_MMA(1, 0, At, B0); PG8_BAR; PG8_SCHED;
            PG8_STAGE(PG8_SB(0, 1), b2 + hstep, voffB);
            PG8_WAIT_V(6); PG8_BAR; PG8_MMA(1, 1, At, B1); PG8_BAR;
            PG8_LDB(B0, 1, 0); PG8_SCHED; PG8_LDA(At, 1, 0); PG8_STAGE(PG8_SA(0, 1), a2 + hstep, voffA);
            PG8_WAIT_L(8); PG8_BAR; PG8_WAIT_L(0); PG8_MMA(0, 0, At, B0); PG8_BAR; PG8_SCHED;
            PG8_LDB(B1, 1, 1); PG8_STAGE(PG8_SB(1, 0), b3, voffB);
            PG8_BAR; PG8_WAIT_L(0); PG8_MMA(0, 1, At, B1); PG8_BAR;
            PG8_LDA(At, 1, 1); PG8_STAGE(PG8_SA(1, 0), a3, voffA);
            PG8_BAR; PG8_WAIT_L(0); PG8_MMA(1, 0, At, B0); PG8_BAR; PG8_SCHED;
            PG8_STAGE(PG8_SB(1, 1), b3 + hstep, voffB);
            PG8_WAIT_V(6); PG8_BAR; PG8_MMA(1, 1, At, B1); PG8_BAR;
            }
        }
        if constexpr (ALIGN_EPI) { if (wr == 0) PG8_BAR; }
        if constexpr (!Epi::AFTER_DRAIN) { E(acc, cur, wr, wc, fr, fq); S.done(cur); }
        if (!has_next) break;
        if constexpr (Epi::HAS_INIT) E.init(acc, nxt, wr, wc, fr, fq);
        else {
#pragma unroll
        for (int a = 0; a < 2; ++a)
#pragma unroll
            for (int b = 0; b < 2; ++b)
#pragma unroll
                for (int m = 0; m < 4; ++m)
#pragma unroll
                    for (int n = 0; n < 2; ++n) acc[a][b][m][n] = (f32x4){0.f, 0.f, 0.f, 0.f};
        }
        cur = nxt; cA = nA; cB = nB; ++ui;
        if constexpr (ALIGN_EPI) { if (wr == 1) PG8_BAR; }
    }
    PG8_WAIT_V(0);
    if constexpr (!ALIGN_EPI) { if (wr == 0) PG8_BAR; }
    PG8_BAR;
    if constexpr (Epi::AFTER_DRAIN) { E.fused(acc, cur, wr, wc, fr, fq, lds, wid, lane); S.done(cur); }
#undef PG8_SA
#undef PG8_SB
#undef PG8_STAGE
#undef PG8_LDA
#undef PG8_LDB
#undef PG8_MMA
#undef PG8_WAIT_V
#undef PG8_WAIT_L
#undef PG8_BAR
#undef PG8_SCHED
}
}
namespace pg8 {
__device__ __forceinline__ float bfu(unsigned short h) { return __uint_as_float((unsigned)h << 16); }
__device__ __forceinline__ void st16_wt(void* p, u32x4 v) { asm volatile("global_store_dwordx4 %0, %1, off sc1\n\ts_nop 1" :: "v"(p), "v"(v) : "memory"); }
__device__ __forceinline__ float sigm(float x) { return __builtin_amdgcn_rcpf(1.0f + __builtin_amdgcn_exp2f(-1.4426950408889634f * x)); }
struct EpiPlain {
    static constexpr bool PERM = true, AFTER_DRAIN = false; static constexpr int MIDK = 0; static constexpr bool HAS_INIT = false;
    bf16_t* O; int ldc; int nrow;
    __device__ __forceinline__ void operator()(const f32x4 (&acc)[2][2][4][2], const Unit& u, int wr, int wc, int fr, int fq) const { run(acc, u, wr, wc, fr, fq, -1); }
    __device__ __forceinline__ void run(const f32x4 (&acc)[2][2][4][2], const Unit& u, int wr, int wc, int fr, int fq, int msel) const {
        const int row0 = u.pm * BM + wr * 64 + fr, col0 = u.pn * BM + wc * 32 + 8 * fq;
#pragma unroll
        for (int ai = 0; ai < 2; ++ai) { if (u.pm * BM + ai * HALF >= nrow) continue;
#pragma unroll
            for (int m = 0; m < 4; ++m) { if (msel >= 0 && m != msel) continue; bf16_t* rowp = O + (size_t)(row0 + ai * HALF + m * 16) * ldc + col0;
#pragma unroll
                for (int bj = 0; bj < 2; ++bj) { const f32x4 v0 = acc[ai][bj][m][0], v1 = acc[ai][bj][m][1];
                    u32x4 w; w.x = cvt_pk_bf16(v0[0], v0[1]); w.y = cvt_pk_bf16(v0[2], v0[3]); w.z = cvt_pk_bf16(v1[0], v1[1]); w.w = cvt_pk_bf16(v1[2], v1[3]);
                    *(u32x4*)(rowp + bj * HALF) = w; } } }
    }
};
template <bool ADD> struct EpiGate {
    static constexpr bool PERM = true, AFTER_DRAIN = false; static constexpr int MIDK = 0; static constexpr bool HAS_INIT = false;
    bf16_t* O; int ldc; const bf16_t* G; int ldg; int nrow;
    __device__ __forceinline__ void operator()(const f32x4 (&acc)[2][2][4][2], const Unit& u, int wr, int wc, int fr, int fq) const { run(acc, u, wr, wc, fr, fq, -1); }
    __device__ __forceinline__ void run(const f32x4 (&acc)[2][2][4][2], const Unit& u, int wr, int wc, int fr, int fq, int msel) const {
        const int row0 = u.pm * BM + wr * 64 + fr, col0 = u.pn * BM + wc * 32 + 8 * fq;
#pragma unroll
        for (int ai = 0; ai < 2; ++ai) { if (u.pm * BM + ai * HALF >= nrow) continue;
#pragma unroll
            for (int m = 0; m < 4; ++m) { if (msel >= 0 && m != msel) continue; const size_t r = (size_t)(row0 + ai * HALF + m * 16); bf16_t* rowp = O + r * ldc + col0; const bf16_t* gp = G + r * ldg + col0;
#pragma unroll
                for (int bj = 0; bj < 2; ++bj) { const f32x4 v0 = acc[ai][bj][m][0], v1 = acc[ai][bj][m][1];
                    const u32x4 gw = *(const u32x4*)(gp + bj * HALF);
                    float o[8];
                    o[0] = v0[0] * sigm(bfu(gw.x & 0xffff)); o[1] = v0[1] * sigm(bfu(gw.x >> 16)); o[2] = v0[2] * sigm(bfu(gw.y & 0xffff)); o[3] = v0[3] * sigm(bfu(gw.y >> 16));
                    o[4] = v1[0] * sigm(bfu(gw.z & 0xffff)); o[5] = v1[1] * sigm(bfu(gw.z >> 16)); o[6] = v1[2] * sigm(bfu(gw.w & 0xffff)); o[7] = v1[3] * sigm(bfu(gw.w >> 16));
                    if (ADD) { const u32x4 pw = *(const u32x4*)(rowp + bj * HALF);
                        o[0] += bfu(pw.x & 0xffff); o[1] += bfu(pw.x >> 16); o[2] += bfu(pw.y & 0xffff); o[3] += bfu(pw.y >> 16);
                        o[4] += bfu(pw.z & 0xffff); o[5] += bfu(pw.z >> 16); o[6] += bfu(pw.w & 0xffff); o[7] += bfu(pw.w >> 16); }
                    u32x4 w; w.x = cvt_pk_bf16(o[0], o[1]); w.y = cvt_pk_bf16(o[2], o[3]); w.z = cvt_pk_bf16(o[4], o[5]); w.w = cvt_pk_bf16(o[6], o[7]);
                    *(u32x4*)(rowp + bj * HALF) = w; } } }
    }
};
struct EpiPlainFull {
    static constexpr bool PERM = true, AFTER_DRAIN = false; static constexpr int MIDK = 0; static constexpr bool HAS_INIT = false;
    bf16_t* O; int ldc;
    __device__ __forceinline__ void operator()(const f32x4 (&acc)[2][2][4][2], const Unit& u, int wr, int wc, int fr, int fq) const {
        const int row0 = u.pm * BM + wr * 64 + fr, col0 = u.pn * BM + wc * 64 + 8 * fq;
#pragma unroll
        for (int ai = 0; ai < 2; ++ai)
#pragma unroll
            for (int m = 0; m < 4; ++m) { bf16_t* rowp = O + (size_t)(row0 + ai * HALF + m * 16) * ldc + col0;
#pragma unroll
                for (int bj = 0; bj < 2; ++bj) { const f32x4 v0 = acc[ai][bj][m][0], v1 = acc[ai][bj][m][1];
                    u32x4 w; w.x = cvt_pk_bf16(v0[0], v0[1]); w.y = cvt_pk_bf16(v0[2], v0[3]); w.z = cvt_pk_bf16(v1[0], v1[1]); w.w = cvt_pk_bf16(v1[2], v1[3]);
                    *(u32x4*)(rowp + bj * 32) = w; } }
    }
};
struct EpiPlainLine {
    static constexpr bool PERM = true, AFTER_DRAIN = false; static constexpr int MIDK = 0; static constexpr bool HAS_INIT = false;
    bf16_t* O; int ldc;
    __device__ __forceinline__ void operator()(const f32x4 (&acc)[2][2][4][2], const Unit& u, int wr, int wc, int fr, int fq) const {
        int z_ = 0; asm volatile("" : "+v"(z_));
        const int row0 = u.pm * BM + wr * 64 + 2 * (fr >> 1) + z_, col0 = u.pn * BM + wc * 64 + 32 * (fr & 1) + 8 * fq;
#pragma unroll
        for (int ai = 0; ai < 2; ++ai)
#pragma unroll
            for (int m = 0; m < 4; ++m)
#pragma unroll
                for (int bj = 0; bj < 2; ++bj) { const f32x4 v0 = acc[ai][bj][m][0], v1 = acc[ai][bj][m][1];
                    u32x4 w; w.x = cvt_pk_bf16(v0[0], v0[1]); w.y = cvt_pk_bf16(v0[2], v0[3]); w.z = cvt_pk_bf16(v1[0], v1[1]); w.w = cvt_pk_bf16(v1[2], v1[3]);
                    *(u32x4*)(O + (size_t)(row0 + ai * HALF + m * 16 + bj) * ldc + col0) = w; }
    }
};
struct EpiNull {
    static constexpr bool PERM = true, AFTER_DRAIN = false; static constexpr int MIDK = 0; static constexpr bool HAS_INIT = false;
    __device__ __forceinline__ void operator()(const f32x4 (&acc)[2][2][4][2], const Unit& u, int wr, int wc, int fr, int fq) const {
#pragma unroll
        for (int ai = 0; ai < 2; ++ai)
#pragma unroll
            for (int bj = 0; bj < 2; ++bj)
#pragma unroll
                for (int m = 0; m < 4; ++m)
#pragma unroll
                    for (int n = 0; n < 2; ++n) asm volatile("" :: "v"(acc[ai][bj][m][n]));
    }
};
struct EpiScratch {
    static constexpr bool PERM = true, AFTER_DRAIN = false; static constexpr int MIDK = 0; static constexpr bool HAS_INIT = false;
    bf16_t* S;
    __device__ __forceinline__ void operator()(const f32x4 (&acc)[2][2][4][2], const Unit& u, int wr, int wc, int fr, int fq) const {
        const int row0 = wr * 64 + fr, col0 = wc * 32 + 8 * fq;
#pragma unroll
        for (int ai = 0; ai < 2; ++ai)
#pragma unroll
            for (int m = 0; m < 4; ++m) { bf16_t* rowp = S + (size_t)(row0 + ai * HALF + m * 16) * 256 + col0;
#pragma unroll
                for (int bj = 0; bj < 2; ++bj) { const f32x4 v0 = acc[ai][bj][m][0], v1 = acc[ai][bj][m][1];
                    u32x4 w; w.x = cvt_pk_bf16(v0[0], v0[1]); w.y = cvt_pk_bf16(v0[2], v0[3]); w.z = cvt_pk_bf16(v1[0], v1[1]); w.w = cvt_pk_bf16(v1[2], v1[3]);
                    *(u32x4*)(rowp + bj * HALF) = w; } }
    }
};
struct EpiMerge {
    static constexpr bool PERM = true, AFTER_DRAIN = false; static constexpr int MIDK_ = 16;
    static constexpr int MIDK = MIDK_; static constexpr bool HAS_INIT = false;
    bf16_t* O; int ldc; const unsigned char* G; size_t ldg; int nrow;
    __device__ __forceinline__ void mid(f32x4 (&acc)[2][2][4][2], const Unit& u, int wr, int wc, int fr, int fq, int msel_) const {
        const int msel = msel_ < 0 ? -1 : (msel_ & 15), bsel = msel_ < 0 ? -1 : ((msel_ >> 4) - 1);
        const int row0 = u.pm * BM + wr * 64 + fr, col0 = u.pn * BM + wc * 32 + 8 * fq;
#pragma unroll
        for (int ai = 0; ai < 2; ++ai) { if (u.pm * BM + ai * HALF >= nrow) continue;
            u32x2 ga_[4][2], gb_[4][2];
#pragma unroll
            for (int m = 0; m < 4; ++m) { if (msel >= 0 && m != msel) continue; const size_t r = (size_t)(row0 + ai * HALF + m * 16);
#pragma unroll
                for (int bj = 0; bj < 2; ++bj) { if (bsel >= 0 && bj != bsel) continue; ga_[m][bj] = *(const u32x2*)(G + r * ldg + col0 + bj * HALF); gb_[m][bj] = *(const u32x2*)(G + r * ldg + 1024 + col0 + bj * HALF); } }
#pragma unroll
            for (int m = 0; m < 4; ++m) { if (msel >= 0 && m != msel) continue;
#pragma unroll
                for (int bj = 0; bj < 2; ++bj) { if (bsel >= 0 && bj != bsel) continue; const unsigned aw[2] = {ga_[m][bj].x, ga_[m][bj].y}, bw[2] = {gb_[m][bj].x, gb_[m][bj].y};
#pragma unroll
                    for (int n = 0; n < 2; ++n)
#pragma unroll
                        for (int q = 0; q < 4; ++q) acc[ai][bj][m][n][q] *= (float)((aw[n] >> (8 * q)) & 0xffu) * __builtin_amdgcn_rcpf((float)((bw[n] >> (8 * q)) & 0xffu)); } } }
    }
    __device__ __forceinline__ void operator()(const f32x4 (&acc)[2][2][4][2], const Unit& u, int wr, int wc, int fr, int fq) const { run(acc, u, wr, wc, fr, fq, -1); }
    __device__ __forceinline__ void run(const f32x4 (&acc)[2][2][4][2], const Unit& u, int wr, int wc, int fr, int fq, int msel_) const {
        const int msel = msel_ < 0 ? -1 : (msel_ & 15), bsel = msel_ < 0 ? -1 : ((msel_ >> 4) - 1);
        const int row0 = u.pm * BM + wr * 64 + fr, col0 = u.pn * BM + wc * 32 + 8 * fq;
#pragma unroll
        for (int ai = 0; ai < 2; ++ai) { if (u.pm * BM + ai * HALF >= nrow) continue;
            u32x2 gb_[4][2];
#pragma unroll
            for (int m = 0; m < 4; ++m) { if (msel >= 0 && m != msel) continue; const size_t r = (size_t)(row0 + ai * HALF + m * 16);
#pragma unroll
                for (int bj = 0; bj < 2; ++bj) { if (bsel >= 0 && bj != bsel) continue; gb_[m][bj] = *(const u32x2*)(G + r * ldg + 1024 + col0 + bj * HALF); } }
#pragma unroll
            for (int m = 0; m < 4; ++m) { if (msel >= 0 && m != msel) continue; const size_t r = (size_t)(row0 + ai * HALF + m * 16); bf16_t* rowp = O + r * ldc + col0;
#pragma unroll
                for (int bj = 0; bj < 2; ++bj) { if (bsel >= 0 && bj != bsel) continue; const unsigned bw[2] = {gb_[m][bj].x, gb_[m][bj].y}; float o[8];
#pragma unroll
                    for (int n = 0; n < 2; ++n)
#pragma unroll
                        for (int q = 0; q < 4; ++q) o[4 * n + q] = acc[ai][bj][m][n][q] * ((float)((bw[n] >> (8 * q)) & 0xffu) * (1.0f / 255.0f));
                    u32x4 w; w.x = cvt_pk_bf16(o[0], o[1]); w.y = cvt_pk_bf16(o[2], o[3]); w.z = cvt_pk_bf16(o[4], o[5]); w.w = cvt_pk_bf16(o[6], o[7]);
                    *(u32x4*)(rowp + bj * HALF) = w; } } }
    }
};
struct EpiResidual {
    static constexpr bool PERM = false, AFTER_DRAIN = false; static constexpr int MIDK = 0; static constexpr bool HAS_INIT = true;
    const float* xa; const float* xb; float* out; int ldc, nrow_a, nrow;
    __device__ __forceinline__ void init(f32x4 (&acc)[2][2][4][2], const Unit& u, int wr, int wc, int fr, int fq) const {
        const int row0 = u.pm * BM + wr * 64 + fr, col0 = u.pn * BM + wc * 32 + 4 * fq;
#pragma unroll
        for (int ai = 0; ai < 2; ++ai)
#pragma unroll
            for (int m = 0; m < 4; ++m) { const int r = row0 + ai * HALF + m * 16; const float* xp = xa + (size_t)r * ldc;
#pragma unroll
                for (int bj = 0; bj < 2; ++bj)
#pragma unroll
                    for (int n = 0; n < 2; ++n) acc[ai][bj][m][n] = __builtin_nontemporal_load((const f32x4*)(xp + col0 + bj * HALF + n * 16)); }
    }
    __device__ __forceinline__ void operator()(const f32x4 (&acc)[2][2][4][2], const Unit& u, int wr, int wc, int fr, int fq) const { run(acc, u, wr, wc, fr, fq, -1); }
    __device__ __forceinline__ void run(const f32x4 (&acc)[2][2][4][2], const Unit& u, int wr, int wc, int fr, int fq, int msel_) const {
        const int msel = msel_ < 0 ? -1 : (msel_ & 15), bsel = msel_ < 0 ? -1 : ((msel_ >> 4) - 1);
        const int row0 = u.pm * BM + wr * 64 + fr, col0 = u.pn * BM + wc * 32 + 4 * fq;
#pragma unroll
        for (int ai = 0; ai < 2; ++ai)
#pragma unroll
            for (int m = 0; m < 4; ++m) { if (msel >= 0 && m != msel) continue; const int r = row0 + ai * HALF + m * 16;
                if (r < nrow) { const float* xp = (r < nrow_a) ? xa + (size_t)r * ldc : xb + (size_t)(r - nrow_a) * ldc; float* op = out + (size_t)r * ldc;
#pragma unroll
                    for (int bj = 0; bj < 2; ++bj) { if (bsel >= 0 && bj != bsel) continue;
#pragma unroll
                        for (int n = 0; n < 2; ++n) { const int c = col0 + bj * HALF + n * 16; f32x4 v = acc[ai][bj][m][n]; if (msel >= 0) v += *(const f32x4*)(xp + c); __builtin_nontemporal_store(v, (f32x4*)(op + c)); } } } }
    }
};
struct EpiInProj {
    static constexpr bool PERM = true, AFTER_DRAIN = false; static constexpr int MIDK = 0; static constexpr bool HAS_INIT = false;
    bf16_t* P; float* out; const f32x4* rope; bf16_t* APL;
    __device__ __forceinline__ void operator()(const f32x4 (&acc)[2][2][4][2], const Unit& u, int wr, int wc, int fr, int fq) const { run(acc, u, wr, wc, fr, fq, -1); }
    __device__ __forceinline__ void run(const f32x4 (&acc)[2][2][4][2], const Unit& u, int wr, int wc, int fr, int fq, int msel) const {
        const int pn = u.pn, rowbase = u.pm * BM + wr * 64 + fr;
        if (pn < 4) {
            const bool isk = pn >= 2; const float sc = isk ? 0.08838834764831845f : 1.0f;
            const int jb = (32 * wc + 8 * fq) & 63, hd = (pn & 1) * 2 + (wc >> 1);
            const int colbase = (isk ? C_RK : C_RQ) + hd * 128 + jb;
#pragma unroll
            for (int ai = 0; ai < 2; ++ai) { if (u.pm * BM + ai * HALF >= MR) continue;
#pragma unroll
              for (int mp = 0; mp < 2; ++mp) {
                f32x4 t1[2][4], t2[2][4];
#pragma unroll
                for (int mm = 0; mm < 2; ++mm) { const int m = 2 * mp + mm; if (msel >= 0 && m != msel) continue; const int r = rowbase + ai * HALF + m * 16;
                    const int pos = (r < MP) ? (r & (TP - 1)) : (16384 + ((r - MP) & 3));
                    const f32x4* c1 = rope + (size_t)(pos >> 7) * 32 + (jb >> 1); const f32x4* c2 = rope + (size_t)(129 + (pos & 127)) * 32 + (jb >> 1);
#pragma unroll
                    for (int q = 0; q < 4; ++q) { t1[mm][q] = c1[q]; t2[mm][q] = c2[q]; } }
#pragma unroll
                for (int mm = 0; mm < 2; ++mm) { const int m = 2 * mp + mm; if (msel >= 0 && m != msel) continue; const int r = rowbase + ai * HALF + m * 16;
                    float o1[8], o2[8];
#pragma unroll
                    for (int n = 0; n < 2; ++n) { const f32x4 a = acc[ai][0][m][n] * sc, b = acc[ai][1][m][n] * sc;
#pragma unroll
                        for (int hp = 0; hp < 2; ++hp) { const f32x4 u1 = t1[mm][2 * n + hp], u2 = t2[mm][2 * n + hp];
                            const float ca = u1[0] * u2[0] - u1[1] * u2[1], sa = u1[1] * u2[0] + u1[0] * u2[1], cb = u1[2] * u2[2] - u1[3] * u2[3], sb = u1[3] * u2[2] + u1[2] * u2[3];
                            o1[4 * n + 2 * hp] = a[2 * hp] * ca - b[2 * hp] * sa; o2[4 * n + 2 * hp] = a[2 * hp] * sa + b[2 * hp] * ca;
                            o1[4 * n + 2 * hp + 1] = a[2 * hp + 1] * cb - b[2 * hp + 1] * sb; o2[4 * n + 2 * hp + 1] = a[2 * hp + 1] * sb + b[2 * hp + 1] * cb; } }
                    bf16_t* dp = P + (size_t)r * INW + colbase;
                    u32x4 w1, w2; w1.x = cvt_pk_bf16(o1[0], o1[1]); w1.y = cvt_pk_bf16(o1[2], o1[3]); w1.z = cvt_pk_bf16(o1[4], o1[5]); w1.w = cvt_pk_bf16(o1[6], o1[7]);
                    w2.x = cvt_pk_bf16(o2[0], o2[1]); w2.y = cvt_pk_bf16(o2[2], o2[3]); w2.z = cvt_pk_bf16(o2[4], o2[5]); w2.w = cvt_pk_bf16(o2[6], o2[7]);
                    *(u32x4*)dp = w1; *(u32x4*)(dp + 64) = w2; } } }
        } else if (pn >= 12 && pn < 24) {
            const bool isk = pn >= 18; const int hd = (isk ? pn - 18 : pn - 12) * 4 + wc, g = hd >> 3, h = hd & 7;
            int zg_ = 0; asm volatile("" : "+v"(zg_));
            const PG8_LAS float* gp = (const PG8_LAS float*)(size_t)(GAINS_OFF + zg_) + (isk ? 64 : 0) + 8 * fq;
            f32x4 gn[2][2];
#pragma unroll
            for (int bj = 0; bj < 2; ++bj)
#pragma unroll
                for (int n = 0; n < 2; ++n) gn[bj][n] = *(const PG8_LAS f32x4*)(gp + bj * 32 + 4 * n);
            const int win = (g == 0) ? 128 : (g == 1 ? 512 : 2048);
            const size_t okp = (g == 0) ? O_KVP0 : (g == 1 ? O_KVP1 : O_KVP2), oks = (g == 0) ? O_KVS0 : (g == 1 ? O_KVS1 : O_KVS2);
#pragma unroll
            for (int ai = 0; ai < 2; ++ai) { if (u.pm * BM + ai * HALF >= MR) continue;
#pragma unroll
                for (int m = 0; m < 4; ++m) { if (msel >= 0 && m != msel) continue; const int r = rowbase + ai * HALF + m * 16;
                    float ss = 0.f;
#pragma unroll
                    for (int bj = 0; bj < 2; ++bj)
#pragma unroll
                        for (int n = 0; n < 2; ++n) { const f32x4 x = acc[ai][bj][m][n]; ss += (x[0] * x[0] + x[1] * x[1]) + (x[2] * x[2] + x[3] * x[3]); }
                    ss += __shfl_xor(ss, 16); ss += __shfl_xor(ss, 32);
                    const float rs = __builtin_amdgcn_rsqf(ss * (1.0f / 64.0f) + EPSF);
                    bf16_t* dp = APL + ((size_t)((isk ? 24 : 0) + hd) * MPAD + apl_row(r, 2 * g)) * 64 + 8 * fq;
                    float* kvp = nullptr;
                    if (isk) { if (r < MP) { const int b = r >> 13, t = r & (TP - 1); if (t >= TP - win) kvp = out + okp + ((size_t)(b * win + (t - (TP - win))) * 2) * 512 + h * 64 + 8 * fq; }
                               else { kvp = out + oks + ((size_t)(r - MP) * 2) * 512 + h * 64 + 8 * fq; } }
#pragma unroll
                    for (int bj = 0; bj < 2; ++bj) { const f32x4 y0 = acc[ai][bj][m][0] * rs * gn[bj][0], y1 = acc[ai][bj][m][1] * rs * gn[bj][1];
                        u32x4 w; w.x = cvt_pk_bf16(y0[0], y0[1]); w.y = cvt_pk_bf16(y0[2], y0[3]); w.z = cvt_pk_bf16(y1[0], y1[1]); w.w = cvt_pk_bf16(y1[2], y1[3]);
                        *(u32x4*)(dp + bj * 32) = w;
                        if (kvp) { *(f32x4*)(kvp + bj * 32) = y0; *(f32x4*)(kvp + bj * 32 + 4) = y1; } } } }
        } else if (pn >= 32) {
            const int gc0 = (pn - 32) * BM + wc * 64 + 8 * fq;
#pragma unroll
            for (int ai = 0; ai < 2; ++ai) { if (u.pm * BM + ai * HALF >= MR) continue;
#pragma unroll
                for (int m = 0; m < 4; ++m) { if (msel >= 0 && m != msel) continue; const int r = rowbase + ai * HALF + m * 16; unsigned char* rowp = (unsigned char*)(P + (size_t)r * INW) + GATE_OFF + gc0;
#pragma unroll
                    for (int bj = 0; bj < 2; ++bj) { unsigned w[2];
#pragma unroll
                        for (int n = 0; n < 2; ++n) { const f32x4 v = acc[ai][bj][m][n]; unsigned q[4];
#pragma unroll
                            for (int e = 0; e < 4; ++e) { const float s = sigm(v[e]) * 255.0f + 0.5f; unsigned t = (unsigned)s; q[e] = t < 1u ? 1u : t; }
                            w[n] = q[0] | (q[1] << 8) | (q[2] << 16) | (q[3] << 24); }
                        u32x2 ww; ww.x = w[0]; ww.y = w[1]; *(u32x2*)(rowp + bj * 32) = ww; } } }
        } else {
            const bool isv = (pn >= 24 && pn < 30), issilu = (pn >= 8 && pn < 12) || pn == 30 || pn == 31;
            const int col0 = pn * BM + wc * 64 + 8 * fq;
#pragma unroll
            for (int ai = 0; ai < 2; ++ai) { if (u.pm * BM + ai * HALF >= MR) continue;
#pragma unroll
                for (int m = 0; m < 4; ++m) { if (msel >= 0 && m != msel) continue; const int r = rowbase + ai * HALF + m * 16;
                    bf16_t* rowp = isv ? APL + ((size_t)(48 + (pn - 24) * 4 + wc) * MPAD + apl_row(r, 2 * (((pn - 24) * 4 + wc) >> 3))) * 64 + 8 * fq : P + (size_t)r * INW + col0;
#pragma unroll
                    for (int bj = 0; bj < 2; ++bj) { f32x4 v0 = acc[ai][bj][m][0], v1 = acc[ai][bj][m][1];
                        if (issilu) {
#pragma unroll
                            for (int q = 0; q < 4; ++q) { v0[q] *= sigm(v0[q]); v1[q] *= sigm(v1[q]); } }
                        u32x4 w; w.x = cvt_pk_bf16(v0[0], v0[1]); w.y = cvt_pk_bf16(v0[2], v0[3]); w.z = cvt_pk_bf16(v1[0], v1[1]); w.w = cvt_pk_bf16(v1[2], v1[3]);
                        *(u32x4*)(rowp + bj * 32) = w;
                        if (isv) { const int hd = (pn - 24) * 4 + wc, g = hd >> 3, h = hd & 7, d0 = 32 * bj + 8 * fq;
                            const int win = (g == 0) ? 128 : (g == 1 ? 512 : 2048);
                            float* kvp = nullptr;
                            if (r < MP) { const int b = r >> 13, t = r & (TP - 1); if (t >= TP - win) kvp = out + ((g == 0) ? O_KVP0 : (g == 1 ? O_KVP1 : O_KVP2)) + ((size_t)(b * win + (t - (TP - win))) * 2 + 1) * 512 + h * 64 + d0; }
                            else kvp = out + ((g == 0) ? O_KVS0 : (g == 1 ? O_KVS1 : O_KVS2)) + ((size_t)(r - MP) * 2 + 1) * 512 + h * 64 + d0;
                            if (kvp) { *(f32x4*)kvp = v0; *(f32x4*)(kvp + 4) = v1; } } } } }
        }
    }
};
__host__ __device__ __forceinline__ int inproj_rowmap(int col) {
    if (col < 1024) { const int tile = col >> 8, hdl = (col >> 7) & 1, half = (col >> 6) & 1, j = col & 63; return tile * 256 + half * 128 + hdl * 64 + j; }
    if (col >= C_AQ && col < C_AV) { const int off = col & 255, base = col - off, head = off >> 6, d = off & 63; return base + (d >> 5) * 128 + head * 32 + (d & 31); }
    { const int off = col & 255, base = col - off, wc = off >> 6, bj = (off >> 5) & 1, x = off & 31; return base + bj * 128 + wc * 32 + x; }
}
template <int K, bool PERM>
__device__ __forceinline__ void g128_accum(PG8_LAS unsigned char* lds, const bf16_t* A, int lda, const bf16_t* Bt, int ldb, int pn, int wc, f32x4 (&c)[2][2]) {
    const int tid = threadIdx.x, wid = __builtin_amdgcn_readfirstlane(tid >> 6), lane = tid & 63, wr = wid >> 2, ms = wid & 3, fr = lane & 15, fq = lane >> 4;
    constexpr int RS = K * 2 + 16, CPR = K / 8, NIT = 64 * CPR / 512;
    u32x4 st[NIT];
#pragma unroll
    for (int it = 0; it < NIT; ++it) { const int id = tid + 512 * it, lrow = id / CPR, ch = id % CPR, bj = lrow >> 5, n = (lrow >> 4) & 1, i = lrow & 15;
        const int brow = pn * BM + bj * HALF + wc * 32 + (PERM ? (8 * (i >> 2) + 4 * n + (i & 3)) : (16 * n + i));
        st[it] = *(const u32x4*)(Bt + (size_t)brow * ldb + ch * 8); }
    const bf16_t* ap = A + (size_t)(wr * 64 + ms * 16 + fr) * lda + 8 * fq;
    constexpr int NS = K / 32;
    bf16x8 af[NS];
#pragma unroll
    for (int s = 0; s < NS; ++s) af[s] = *(const bf16x8*)(ap + 32 * s);
#pragma unroll
    for (int it = 0; it < NIT; ++it) { const int id = tid + 512 * it, lrow = id / CPR, ch = id % CPR; *(PG8_LAS u32x4*)(lds + lrow * RS + ch * 16) = st[it]; }
    __syncthreads();
    const PG8_LAS unsigned char* bl = lds + fr * RS + 16 * fq;
#pragma unroll
    for (int s = 0; s < NS; ++s) {
#pragma unroll
        for (int bj = 0; bj < 2; ++bj)
#pragma unroll
            for (int n = 0; n < 2; ++n) { const bf16x8 bf = *(const PG8_LAS bf16x8*)(bl + (bj * 32 + n * 16) * RS + (32 * s) * 2); c[bj][n] = __builtin_amdgcn_mfma_f32_16x16x32_bf16(bf, af[s], c[bj][n], 0, 0, 0); }
    }
    __syncthreads();
}
#define G128_FILL(acc, c) do { _Pragma("unroll") for (int a_ = 0; a_ < 2; ++a_) _Pragma("unroll") for (int b_ = 0; b_ < 2; ++b_) _Pragma("unroll") for (int m_ = 0; m_ < 4; ++m_) _Pragma("unroll") for (int n_ = 0; n_ < 2; ++n_) \
        acc[a_][b_][m_][n_] = (a_ == 0) ? c[b_][n_] : (f32x4){0.f, 0.f, 0.f, 0.f}; } while (0)
template <int K, class Epi>
__device__ __forceinline__ void gemm128_direct(PG8_LAS unsigned char* lds, const bf16_t* A, const bf16_t* Bt, int pm, int unit, const Epi& E) {
    const int tid = threadIdx.x, wid = __builtin_amdgcn_readfirstlane(tid >> 6), lane = tid & 63, wr = wid >> 2, ms = wid & 3, fr = lane & 15, fq = lane >> 4;
    const int pn = unit >> 2, wc = unit & 3;
    f32x4 c[2][2];
#pragma unroll
    for (int b = 0; b < 2; ++b)
#pragma unroll
        for (int n = 0; n < 2; ++n) c[b][n] = (f32x4){0.f, 0.f, 0.f, 0.f};
    g128_accum<K, Epi::PERM>(lds, A, K, Bt, K, pn, wc, c);
    f32x4 acc[2][2][4][2]; G128_FILL(acc, c);
    E.run(acc, Unit{pm, pn}, wr, wc, fr, fq, ms);
}
__device__ __forceinline__ void gemm128_merge(PG8_LAS unsigned char* lds, const bf16_t* A, const bf16_t* Bt, int pm, int unit, const EpiMerge& E) {
    const int tid = threadIdx.x, wid = __builtin_amdgcn_readfirstlane(tid >> 6), lane = tid & 63, wr = wid >> 2, ms = wid & 3, fr = lane & 15, fq = lane >> 4;
    const int pn = unit >> 2, wc = unit & 3;
    f32x4 c[2][2];
#pragma unroll
    for (int b = 0; b < 2; ++b)
#pragma unroll
        for (int n = 0; n < 2; ++n) c[b][n] = (f32x4){0.f, 0.f, 0.f, 0.f};
    g128_accum<1024, true>(lds, A, 1536, Bt, 1536, pn, wc, c);
    { f32x4 acc[2][2][4][2]; G128_FILL(acc, c); E.mid(acc, Unit{pm, pn}, wr, wc, fr, fq, ms);
#pragma unroll
      for (int b = 0; b < 2; ++b)
#pragma unroll
          for (int n = 0; n < 2; ++n) { c[b][n] = (ms == 0) ? acc[0][b][0][n] : (ms == 1) ? acc[0][b][1][n] : (ms == 2) ? acc[0][b][2][n] : acc[0][b][3][n]; } }
    g128_accum<512, true>(lds, A + 1024, 1536, Bt + 1024, 1536, pn, wc, c);
    f32x4 acc[2][2][4][2]; G128_FILL(acc, c);
    E.run(acc, Unit{pm, pn}, wr, wc, fr, fq, ms);
}
template <int K, int KH, class Epi>
__device__ __forceinline__ void gemm128_half(PG8_LAS unsigned char* lds, const bf16_t* A, int lda, const bf16_t* Bt, int ldb, int pm, int unit, const Epi& E) {
    const int tid = threadIdx.x, wid = __builtin_amdgcn_readfirstlane(tid >> 6), lane = tid & 63, wr = wid >> 2, ms = wid & 3, fr = lane & 15, fq = lane >> 4;
    const int pn = unit >> 3, wc = (unit >> 1) & 3, bj = unit & 1;
    constexpr int RS = K * 2 + 16, CPR = K / 8, NIT = 32 * CPR / 512, NS = K / 32;
    u32x4 st[NIT];
#pragma unroll
    for (int it = 0; it < NIT; ++it) { const int id = tid + 512 * it, lrow = id / CPR, ch = id % CPR, n = lrow >> 4, i = lrow & 15;
        const int brow = pn * BM + bj * HALF + wc * 32 + (Epi::PERM ? (8 * (i >> 2) + 4 * n + (i & 3)) : (16 * n + i));
        st[it] = *(const u32x4*)(Bt + (size_t)brow * ldb + ch * 8); }
    const bf16_t* ap = A + (size_t)(wr * 64 + ms * 16 + fr) * lda + 8 * fq;
    bf16x8 af[16];
#pragma unroll
    for (int s = 0; s < 16; ++s) af[s] = *(const bf16x8*)(ap + 32 * s);
#pragma unroll
    for (int it = 0; it < NIT; ++it) { const int id = tid + 512 * it, lrow = id / CPR, ch = id % CPR; *(PG8_LAS u32x4*)(lds + lrow * RS + ch * 16) = st[it]; }
    __syncthreads();
    f32x4 c[2] = {(f32x4){0.f, 0.f, 0.f, 0.f}, (f32x4){0.f, 0.f, 0.f, 0.f}};
    const PG8_LAS unsigned char* bl = lds + fr * RS + 16 * fq;
    const int mcode = ms | ((1 + bj) << 4);
#pragma unroll
    for (int h2 = 0; h2 < NS / 16; ++h2) {
        bf16x8 an[16];
        if (h2 + 1 < NS / 16) {
#pragma unroll
            for (int s = 0; s < 16; ++s) an[s] = *(const bf16x8*)(ap + 512 * (h2 + 1) + 32 * s);
        }
#pragma unroll
        for (int s = 0; s < 16; ++s) {
            if (KH > 0 && 16 * h2 + s == KH / 32) { f32x4 acc[2][2][4][2];
#pragma unroll
                for (int a_ = 0; a_ < 2; ++a_)
#pragma unroll
                    for (int b_ = 0; b_ < 2; ++b_)
#pragma unroll
                        for (int m_ = 0; m_ < 4; ++m_)
#pragma unroll
                            for (int n_ = 0; n_ < 2; ++n_) acc[a_][b_][m_][n_] = (a_ == 0) ? c[n_] : (f32x4){0.f, 0.f, 0.f, 0.f};
                if constexpr (KH > 0) E.mid(acc, Unit{pm, pn}, wr, wc, fr, fq, mcode);
#pragma unroll
                for (int n_ = 0; n_ < 2; ++n_) c[n_] = (bj == 0) ? ((ms == 0) ? acc[0][0][0][n_] : (ms == 1) ? acc[0][0][1][n_] : (ms == 2) ? acc[0][0][2][n_] : acc[0][0][3][n_])
                                                                 : ((ms == 0) ? acc[0][1][0][n_] : (ms == 1) ? acc[0][1][1][n_] : (ms == 2) ? acc[0][1][2][n_] : acc[0][1][3][n_]); }
#pragma unroll
            for (int n = 0; n < 2; ++n) { const bf16x8 bf = *(const PG8_LAS bf16x8*)(bl + (n * 16) * RS + (512 * h2 + 32 * s) * 2); c[n] = __builtin_amdgcn_mfma_f32_16x16x32_bf16(bf, af[s], c[n], 0, 0, 0); }
        }
        if (h2 + 1 < NS / 16) {
#pragma unroll
            for (int s = 0; s < 16; ++s) af[s] = an[s];
        }
    }
    f32x4 acc[2][2][4][2];
#pragma unroll
    for (int a_ = 0; a_ < 2; ++a_)
#pragma unroll
        for (int b_ = 0; b_ < 2; ++b_)
#pragma unroll
            for (int m_ = 0; m_ < 4; ++m_)
#pragma unroll
                for (int n_ = 0; n_ < 2; ++n_) acc[a_][b_][m_][n_] = (a_ == 0) ? c[n_] : (f32x4){0.f, 0.f, 0.f, 0.f};
    E.run(acc, Unit{pm, pn}, wr, wc, fr, fq, mcode);
    __syncthreads();
}
}
#define XB_TMO      128
#define XB_XCNT(j)  (256  + 64 * (j))
#define XB_XSUB(j)  (1280 + 64 * (j))
#define XB_XGEN(j)  (2304 + 64 * (j))
#define XB_TOP      3328
#define XB_TOPGEN   3392
#define XB_SSUB(i, j) (3520 + 1088 * (i) + 64 * (j))
#define XB_STOP(i)    (3520 + 1088 * (i) + 1024)
#define XCD_BAR_WORDS 12224
#define XB_SPIN_CAP (1u << 18)

__device__ __forceinline__ unsigned xb_ld(unsigned* p)              { return __hip_atomic_load(p, __ATOMIC_RELAXED, __HIP_MEMORY_SCOPE_AGENT); }
__device__ __forceinline__ unsigned xb_add(unsigned* p, unsigned v) { return __hip_atomic_fetch_add(p, v, __ATOMIC_RELAXED, __HIP_MEMORY_SCOPE_AGENT); }
__device__ __forceinline__ unsigned xb_xcc_id() { return (unsigned)__builtin_amdgcn_s_getreg((3 << 11) | 20) & 0xFu; }
#define XB_SPIN(cond, bar) do { unsigned _sp = 0; while (cond) { __builtin_amdgcn_s_sleep(1); \
    if ((++_sp & 255u) == 0u) { if (xb_ld(&(bar)[XB_TMO])) break; if (_sp > XB_SPIN_CAP) { atomicAdd(&(bar)[XB_TMO], 1u); break; } } } } while (0)

struct XcdBarrier {
    unsigned* bar; unsigned x;
    volatile LAS unsigned* st;
};

__device__ __forceinline__ XcdBarrier xcd_barrier_post(unsigned* bar, volatile LAS unsigned* st) {
    XcdBarrier b; b.bar = bar; b.x = xb_xcc_id(); b.st = st;
    if (threadIdx.x == 0) (void)xb_add(&bar[XB_XCNT(b.x)], 1u);
    return b;
}
__device__ __forceinline__ void xcd_barrier_complete(unsigned* bar, unsigned x, unsigned& nloc, unsigned& nx) {
    const unsigned G = gridDim.x * gridDim.y * gridDim.z;
    unsigned sum, cnt, mine, sp = 0u;
    for (;;) {
        sum = 0u; cnt = 0u; mine = 0u;
#pragma unroll
        for (unsigned j = 0; j < 16; ++j) { const unsigned c = xb_ld(&bar[XB_XCNT(j)]); sum += c; cnt += (c > 0u) ? 1u : 0u; mine = (j == x) ? c : mine; }
        if (sum == G) break;
        __builtin_amdgcn_s_sleep(1);
        if ((++sp & 255u) == 0u) { if (xb_ld(&bar[XB_TMO])) break; if (sp > XB_SPIN_CAP) { atomicAdd(&bar[XB_TMO], 1u); break; } }
    }
    nloc = mine > 0u ? mine : 1u; nx = cnt > 0u ? cnt : 1u;
}

__device__ __forceinline__ void xcd_barrier(const XcdBarrier& b) {
    asm volatile("s_waitcnt vmcnt(0)" ::: "memory");
    __syncthreads();
    if (threadIdx.x == 0) {
        unsigned* bar = b.bar;
        __builtin_amdgcn_s_waitcnt(0);
        unsigned nloc = b.st[0], nx = b.st[1];
        if (nloc == 0u) { xcd_barrier_complete(bar, b.x, nloc, nx); b.st[0] = nloc; b.st[1] = nx; }
        const unsigned old = xb_add(&bar[XB_XSUB(b.x)], 1u);
        const unsigned gen = old / nloc;
        if (old + 1u == (gen + 1u) * nloc) {
            __builtin_amdgcn_fence(__ATOMIC_RELEASE, "agent");
            asm volatile("s_waitcnt vmcnt(0)" ::: "memory");
            const unsigned og = xb_add(&bar[XB_TOP], 1u);
            const unsigned tg = og / nx;
            if (og + 1u == (tg + 1u) * nx) xb_add(&bar[XB_TOPGEN], 1u);
            else XB_SPIN(xb_ld(&bar[XB_TOPGEN]) == tg, bar);
            __builtin_amdgcn_fence(__ATOMIC_ACQUIRE, "agent");
            xb_add(&bar[XB_XGEN(b.x)], 1u);
            asm volatile("s_waitcnt vmcnt(0)" ::: "memory");
        } else {
            XB_SPIN(xb_ld(&bar[XB_XGEN(b.x)]) == gen, bar);
            __builtin_amdgcn_fence(__ATOMIC_ACQUIRE, "agent");
            asm volatile("s_waitcnt vmcnt(0)" ::: "memory");
        }
    }
    __syncthreads();
}


__device__ __forceinline__ void xcd_split_arrive(const XcdBarrier& b, int id) {
    asm volatile("s_waitcnt vmcnt(0)" ::: "memory");
    __syncthreads();
    if (threadIdx.x == 0) {
        __builtin_amdgcn_s_waitcnt(0);
        const unsigned nloc = b.st[0];
        const unsigned old = xb_add(&b.bar[XB_SSUB(id, b.x)], 1u);
        if (old + 1u == nloc) { __builtin_amdgcn_fence(__ATOMIC_RELEASE, "agent"); asm volatile("s_waitcnt vmcnt(0)" ::: "memory"); xb_add(&b.bar[XB_STOP(id)], 1u); }
    }
}
__device__ __forceinline__ void xcd_split_wait(const XcdBarrier& b, int id) {
    if (threadIdx.x == 0) {
        const unsigned nx = b.st[1];
        XB_SPIN(xb_ld(&b.bar[XB_STOP(id)]) < nx, b.bar);
        __builtin_amdgcn_fence(__ATOMIC_ACQUIRE, "agent");
        asm volatile("s_waitcnt vmcnt(0)" ::: "memory");
    }
    __syncthreads();
}
struct Frame {
    LAS unsigned char* lds;
    volatile LAS unsigned* MISC;
    gu32* ctl;
    int tid, lane, wave;
    int vcu, G;
    const float *xp, *xs, *c128, *c512, *c2048, *state, *w_norm, *w_in, *q_norm, *k_norm, *rel_bias, *ret_norm, *w_pr, *w_pa, *w_out;
    float* out;
    bf16 *Wt_in, *Wt_pr, *Wt_pa, *Wt_out, *XB, *P, *SC, *GA, *GB, *MG;
    float *TB, *L, *OGS, *LS;
    bf16 *OG, *KV, *APL;
    f32x2* ROPE;
};

template <bool MAP> __device__ __forceinline__ void p0_transpose_item(const float* W, int K, int N, bf16* WT, int ldw, LAS float* scr, int item, int lane) {
    const int nblk = N / 32, kb = item / nblk, nb = item % nblk, k0 = 64 * kb, n0 = 32 * nb;
    f32x4 x[8];
#pragma unroll
    for (int i = 0; i < 8; ++i) x[i] = __builtin_nontemporal_load((const GAS f32x4*)(W + (size_t)(k0 + 8 * i + (lane >> 3)) * N + n0 + 4 * (lane & 7)));
#pragma unroll
    for (int i = 0; i < 8; ++i) { LAS float* d = scr + (8 * i + (lane >> 3)) * 33 + 4 * (lane & 7); d[0] = x[i].x; d[1] = x[i].y; d[2] = x[i].z; d[3] = x[i].w; }
    LDS_WAIT(); asm volatile("" ::: "memory");
    const int c = lane & 7;
#pragma unroll
    for (int j = 0; j < 4; ++j) { const int n = (lane >> 3) + 8 * j; const LAS float* s = scr + (8 * c) * 33 + n;
        v4u o; o.x = pk2(s[0 * 33], s[1 * 33]); o.y = pk2(s[2 * 33], s[3 * 33]); o.z = pk2(s[4 * 33], s[5 * 33]); o.w = pk2(s[6 * 33], s[7 * 33]);
        const int drow = MAP ? pg8::inproj_rowmap(n0 + n) : (n0 + n);
        *(GAS v4u*)(WT + (size_t)drow * ldw + k0 + 8 * c) = o; }
    LDS_WAIT(); asm volatile("" ::: "memory");
}
__device__ __forceinline__ int t5_bucket(int d) {
    if (d < 16) return d;
    int large = 16 + (int)(log((double)d / 16.0) / log(128.0) * 16.0);
    return large < 31 ? large : 31;
}
__device__ __forceinline__ void p0_prologue(Frame& F) {
    LAS float* scr = (LAS float*)(F.lds + RING_OFF + F.wave * 16384);
    const int gw = F.vcu * NWAVES + F.wave, NGW = F.G * NWAVES;
    { const int e = gw * 64 + F.lane;
      if (e < (129 + 128) * 64) { const int p = e >> 6, j = e & 63; const double inv = pow(10000.0, -(double)j / 64.0);
          const double ang = (p < 129) ? (double)(128 * p) * inv : (double)(p - 129) * inv; F.ROPE[e] = (f32x2){(float)cos(ang), (float)sin(ang)}; } }
    const int gwb = gw - 1024;
    if (gwb >= 0 && gwb * 64 < 24 * 129) {
        float mq = fabsf(F.q_norm[F.lane]), mk = fabsf(F.k_norm[F.lane]), mb = 0.f;
        for (int e = F.lane; e < 32 * 24; e += 64) mb = fmaxf(mb, fabsf(F.rel_bias[e]));
#pragma unroll
        for (int o = 1; o < 64; o <<= 1) { mq = fmaxf(mq, __shfl_xor(mq, o)); mk = fmaxf(mk, __shfl_xor(mk, o)); mb = fmaxf(mb, __shfl_xor(mb, o)); }
        const float Cref = 8.0f * mq * mk + mb;
        const int e = gwb * 64 + F.lane;
        if (e < 24 * 129) { const int gh = e / 129, m = e % 129, g = gh >> 3; const int dil = (g == 0) ? 1 : (g == 1 ? 4 : 16);
            const float tv = (F.rel_bias[t5_bucket(dil * m) * 24 + gh] - Cref) * 1.4426950408889634f;
            F.TB[gh * TB_STRIDE + m] = tv; F.TB[TBG_OFF + gh * TBL_STRIDE + 16 + m] = tv; }
        for (int q = e; q < 24 * 47; q += 49 * 64) { const int gh = q / 47, i = q % 47; F.TB[TBG_OFF + gh * TBL_STRIDE + (i < 16 ? i : 129 + i)] = -1e30f; }
    }
    { const GAS f32x4* gr = (const GAS f32x4*)F.w_norm + F.lane; f32x4 g[4];
#pragma unroll
      for (int j = 0; j < 4; ++j) g[j] = gr[64 * j];
      for (int m0 = gw * 4; m0 < MR; m0 += NGW * 4) {
        f32x4 v[4][4];
#pragma unroll
        for (int q = 0; q < 4; ++q) { const int m = m0 + q; const float* xrow = (m < MP) ? F.xp + (size_t)m * DM : F.xs + (size_t)(m - MP) * DM; const GAS f32x4* xr = (const GAS f32x4*)xrow + F.lane;
#pragma unroll
            for (int j = 0; j < 4; ++j) v[q][j] = __builtin_nontemporal_load(xr + 64 * j); }
#pragma unroll
        for (int q = 0; q < 4; ++q) { float s = 0.f;
#pragma unroll
            for (int j = 0; j < 4; ++j) s += (v[q][j].x * v[q][j].x + v[q][j].y * v[q][j].y) + (v[q][j].z * v[q][j].z + v[q][j].w * v[q][j].w);
            const float rs = frsq(wave_sum(s) * (1.f / DM) + EPSF);
            GAS unsigned long long* o8 = (GAS unsigned long long*)(F.XB + (size_t)(m0 + q) * DM) + F.lane;
#pragma unroll
            for (int j = 0; j < 4; ++j) { const f32x4 y = v[q][j] * rs * g[j]; o8[64 * j] = (unsigned long long)pk2(y.x, y.y) | ((unsigned long long)pk2(y.z, y.w) << 32); } }
      } }
    constexpr int I_IN = (DM / 64) * (INW / 32), I_PR = (1024 / 64) * (DM / 32), I_PA = (512 / 64) * (DM / 32), I_OUT = (DM / 64) * (DM / 32);
    (void)I_PR; (void)I_PA; (void)I_OUT;
    for (int it = gw; it < I_IN; it += NGW) p0_transpose_item<true>(F.w_in, DM, INW, F.Wt_in, DM, scr, it, F.lane);
}
__device__ __forceinline__ void p1_late_weights(Frame& F, int wfree, int nfree) {
    LAS float* scr = (LAS float*)(F.lds + RING_OFF + F.wave * 16384);
    constexpr int I_PR = (1024 / 64) * (DM / 32), I_PA = (512 / 64) * (DM / 32), I_OUT = (DM / 64) * (DM / 32);
    for (int it = wfree * NWAVES + F.wave; it < I_PR + I_PA + I_OUT; it += nfree * NWAVES) {
        int r = it;
        if (r < I_PR) { p0_transpose_item<false>(F.w_pr, 1024, DM, F.Wt_pr, 1536, scr, r, F.lane); continue; } r -= I_PR;
        if (r < I_PA) { p0_transpose_item<false>(F.w_pa, 512, DM, F.Wt_pr + 1024, 1536, scr, r, F.lane); continue; } r -= I_PA;
        p0_transpose_item<false>(F.w_out, DM, DM, F.Wt_out, DM, scr, r, F.lane);
    }
    __syncthreads();
}

__device__ __forceinline__ void p_touch(Frame& F, const float* p, size_t nfloats) {
    const size_t n4 = nfloats / 4, gt = (size_t)blockIdx.x * 512 + F.tid, NT = (size_t)F.G * 512;
    f32x4 a = (f32x4){0.f, 0.f, 0.f, 0.f};
    for (size_t i = gt; i < n4; i += NT * 8) {
        f32x4 v[8];
#pragma unroll
        for (int j = 0; j < 8; ++j) { const size_t k = i + j * NT; v[j] = (k < n4) ? *(const GAS f32x4*)(p + 4 * k) : (f32x4){0.f, 0.f, 0.f, 0.f}; }
#pragma unroll
        for (int j = 0; j < 8; ++j) a += v[j];
    }
    if (a[0] + a[1] + a[2] + a[3] == 1.2345e-30f) F.TB[3000] = a[0];
}
constexpr int RS_K = 272, RS_V = 528;
__device__ __forceinline__ float head_log2g(int h) { return log2f(1.0f - exp2f(-5.0f - (float)h)); }
__device__ __forceinline__ void ret_kv_unit(Frame& F, int u) {
    const int c = u & 63, h = (u >> 6) & 3, b = u >> 8;
    const int tid = F.tid, lane = F.lane, w = F.wave;
    LAS unsigned char* ks = F.lds; LAS unsigned char* vs = F.lds + 128 * RS_K;
    const bf16* Pr = F.P + (size_t)(b * TP + c * 128) * INW;
    const float l2g = head_log2g(h);
    { v4u kx[4], vx[8];
#pragma unroll
      for (int it = 0; it < 4; ++it) { const int id = tid + 512 * it, row = id >> 4, ch = id & 15; kx[it] = *(const GAS v4u*)(Pr + (size_t)row * INW + C_RK + h * 128 + ch * 8); }
#pragma unroll
      for (int it = 0; it < 8; ++it) { const int id = tid + 512 * it, row = id >> 5, ch = id & 31; vx[it] = *(const GAS v4u*)(Pr + (size_t)row * INW + C_RV + h * 256 + ch * 8); }
#pragma unroll
      for (int it = 0; it < 4; ++it) { const int id = tid + 512 * it, row = id >> 4, ch = id & 15; const v4u x = kx[it]; const float kd = fexp2((float)(127 - row) * l2g);
        v4u y; y.x = pk2(bflo(x.x) * kd, bfhi(x.x) * kd); y.y = pk2(bflo(x.y) * kd, bfhi(x.y) * kd); y.z = pk2(bflo(x.z) * kd, bfhi(x.z) * kd); y.w = pk2(bflo(x.w) * kd, bfhi(x.w) * kd);
        *(LAS v4u*)(ks + row * RS_K + ch * 16) = y; }
#pragma unroll
      for (int it = 0; it < 8; ++it) { const int id = tid + 512 * it, row = id >> 5, ch = id & 31; *(LAS v4u*)(vs + row * RS_V + ch * 16) = vx[it]; } }
    __syncthreads();
    const int g4 = lane >> 4, q4 = (lane & 15) >> 2, p4 = lane & 3, fr = lane & 15;
    f32x4 acc[8][2];
#pragma unroll
    for (int a = 0; a < 8; ++a) { acc[a][0] = (f32x4){0.f, 0.f, 0.f, 0.f}; acc[a][1] = (f32x4){0.f, 0.f, 0.f, 0.f}; }
#pragma unroll
    for (int s = 0; s < 4; ++s) {
        const int t0 = 32 * s + 8 * g4 + q4;
        bf16x8 vf[2];
#pragma unroll
        for (int j = 0; j < 2; ++j) { const LAS unsigned char* a = vs + t0 * RS_V + (32 * w + 16 * j + 4 * p4) * 2; vf[j] = cat8(vtr(a), vtr(a + 4 * RS_V)); }
#pragma unroll
        for (int i0 = 0; i0 < 8; i0 += 4) { s16x4 ka_[4], kb_[4];
#pragma unroll
            for (int i = 0; i < 4; ++i) { const LAS unsigned char* a = ks + t0 * RS_K + (16 * (i0 + i) + 4 * p4) * 2; ka_[i] = vtr(a); kb_[i] = vtr(a + 4 * RS_K); }
#pragma unroll
            for (int i = 0; i < 4; ++i) { const bf16x8 kf = cat8(ka_[i], kb_[i]); acc[i0 + i][0] = MFMA16(kf, vf[0], acc[i0 + i][0]); acc[i0 + i][1] = MFMA16(kf, vf[1], acc[i0 + i][1]); } }
    }
    bf16* dst = F.KV + (size_t)u * 32768;
#pragma unroll
    for (int i = 0; i < 8; ++i)
#pragma unroll
        for (int j = 0; j < 2; ++j) { v2u w2; w2.x = pk2(acc[i][j][0], acc[i][j][1]); w2.y = pk2(acc[i][j][2], acc[i][j][3]); *(GAS v2u*)(dst + (size_t)(32 * w + 16 * j + fr) * 128 + 16 * i + 4 * g4) = w2; }
    __syncthreads();
}

constexpr int RS_A = 144;
constexpr int ATT_ROWS = 272;
constexpr int ATT_UNITS = 3 * NB * 8 * 64;
struct AttnPre { v4u k[5], v[5]; bf16x8 q0, q1; };
__device__ __forceinline__ void attn_decode(int u, int& g, int& b, int& h, int& r, int& j0, int& dil) {
    const int blkcls = u & 63; h = (u >> 6) & 7; b = (u >> 9) & 1; g = u >> 10;
    dil = (g == 0) ? 1 : (g == 1 ? 4 : 16);
    const int nblk = 64 / dil; r = blkcls / nblk; j0 = (blkcls % nblk) * 128;
}
__device__ __forceinline__ void attn_prefetch(Frame& F, int u, AttnPre& R) {
    int g, b, h, r, j0, dil; attn_decode(u, g, b, h, r, j0, dil);
    const size_t cls0 = (size_t)(b * TP + r * (TP / dil));
    const bf16* Kb = F.APL + ((size_t)(24 + g * 8 + h) * MPAD + cls0) * 64 + (F.tid & 7) * 8; const bf16* Vb = Kb + (size_t)24 * MPAD * 64;
    const int rr0 = F.tid >> 3;
#pragma unroll
    for (int it = 0; it < 5; ++it) { int jk = j0 - 128 + rr0 + 64 * it; jk = jk < 0 ? 0 : jk; if (it == 4) jk = jk > j0 + 127 ? j0 + 127 : jk;
        R.k[it] = *(const GAS v4u*)(Kb + (size_t)jk * 64); R.v[it] = *(const GAS v4u*)(Vb + (size_t)jk * 64); }
    { const bf16* qp = F.APL + ((size_t)(g * 8 + h) * MPAD + cls0 + (j0 + 16 * F.wave + (F.lane & 15))) * 64 + 8 * (F.lane >> 4);
      R.q0 = *(const GAS bf16x8*)(qp); R.q1 = *(const GAS bf16x8*)(qp + 32); }
}
template <bool FINAL> __device__ __forceinline__ void attn_unit(Frame& F, int u, int unext, AttnPre& R) {
    int g, b, h, r, j0, dil; attn_decode(u, g, b, h, r, j0, dil);
    const int tid = F.tid, lane = F.lane, w = F.wave, fr = lane & 15, fq = lane >> 4;
    LAS unsigned char* ks = F.lds; LAS unsigned char* vs = F.lds + ATT_ROWS * RS_A; const LAS float* tb = (const LAS float*)(F.lds + 2 * ATT_ROWS * RS_A) + (g * 8 + h) * TBL_STRIDE;
#pragma unroll
    for (int it = 0; it < 5; ++it) { const int id = tid + 512 * it, rr = id >> 3, ch = id & 7;
        if (rr < ATT_ROWS) { *(LAS v4u*)(ks + rr * RS_A + ch * 16) = R.k[it]; *(LAS v4u*)(vs + rr * RS_A + ch * 16) = R.v[it]; } }
    const int tq = r + dil * (j0 + 16 * w + fr);
    const bf16x8 qf0 = R.q0, qf1 = R.q1;
    __syncthreads();
    v2u p1[4], p2[4], ag[4]; float la = 0.f, lb = 0.f;
    if constexpr (FINAL) { const size_t rowf = (size_t)b * TP + tq;
        const bf16* o1 = F.OG + ((size_t)1 * MP + rowf) * 512 + h * 64 + 4 * fq; const bf16* o2 = F.OG + ((size_t)2 * MP + rowf) * 512 + h * 64 + 4 * fq;
        const bf16* agp = F.P + rowf * INW + C_AG + h * 64 + 4 * fq;
#pragma unroll
        for (int d = 0; d < 4; ++d) { p1[d] = *(const GAS v2u*)(o1 + 16 * d); p2[d] = *(const GAS v2u*)(o2 + 16 * d); ag[d] = *(const GAS v2u*)(agp + 16 * d); }
        la = F.L[((size_t)1 * MP + rowf) * 8 + h]; lb = F.L[((size_t)2 * MP + rowf) * 8 + h];
        __builtin_amdgcn_sched_barrier(0); }
    if (unext >= 0) attn_prefetch(F, unext, R);
    const LAS float* tbl = tb + (16 + 128 + fr - 4 * fq);
    f32x4 p[10]; float lsum = 0.f;
#pragma unroll
    for (int n0 = 0; n0 < 9; n0 += 3) { bf16x8 k0[3], k1[3]; f32x4 s[3];
#pragma unroll
        for (int j = 0; j < 3; ++j) { const int n = n0 + j; const LAS unsigned char* ka = ks + (16 * w + 16 * n + fr) * RS_A + 16 * fq;
            k0[j] = *(const LAS bf16x8*)(ka); k1[j] = *(const LAS bf16x8*)(ka + 64);
            s[j] = (f32x4){tbl[-16 * n], tbl[-16 * n - 1], tbl[-16 * n - 2], tbl[-16 * n - 3]}; }
#pragma unroll
        for (int j = 0; j < 3; ++j) { s[j] = MFMA16(k0[j], qf0, s[j]); s[j] = MFMA16(k1[j], qf1, s[j]); }
#pragma unroll
        for (int j = 0; j < 3; ++j)
#pragma unroll
            for (int e = 0; e < 4; ++e) p[n0 + j][e] = __builtin_amdgcn_exp2f(s[j][e]);
    }
    if (j0 == 0) {
#pragma unroll
        for (int n = 0; n < 9; ++n)
#pragma unroll
            for (int e = 0; e < 4; ++e) { const int jk = 16 * w + 16 * n + 4 * fq + e - 128; if (jk < 0) p[n][e] = 0.f; }
    }
#pragma unroll
    for (int n = 0; n < 9; ++n) lsum += (p[n][0] + p[n][1]) + (p[n][2] + p[n][3]);
    p[9] = (f32x4){0.f, 0.f, 0.f, 0.f};
    f32x4 o[4];
#pragma unroll
    for (int d = 0; d < 4; ++d) o[d] = (f32x4){0.f, 0.f, 0.f, 0.f};
    const int q4 = (lane & 15) >> 2, p4 = lane & 3;
#pragma unroll
    for (int st = 0; st < 5; ++st) {
        const bf16x8 pf = pack8(p[2 * st][0], p[2 * st][1], p[2 * st][2], p[2 * st][3], p[2 * st + 1][0], p[2 * st + 1][1], p[2 * st + 1][2], p[2 * st + 1][3]);
        const LAS unsigned char* va = vs + (16 * w + 32 * st + 4 * fq + q4) * RS_A + 8 * p4;
        s16x4 va_[4], vb_[4];
#pragma unroll
        for (int d = 0; d < 4; ++d) { va_[d] = vtr(va + 32 * d); vb_[d] = vtr(va + 16 * RS_A + 32 * d); }
#pragma unroll
        for (int d = 0; d < 4; ++d) o[d] = MFMA16(cat8(va_[d], vb_[d]), pf, o[d]);
    }
    lsum += __shfl_xor(lsum, 16); lsum += __shfl_xor(lsum, 32);
    const size_t row = (size_t)b * TP + tq;
    if constexpr (!FINAL) {
        bf16* og = F.OG + ((size_t)g * MP + row) * 512 + h * 64 + 4 * fq;
#pragma unroll
        for (int d = 0; d < 4; ++d) { v2u w2; w2.x = pk2(o[d][0], o[d][1]); w2.y = pk2(o[d][2], o[d][3]); *(GAS v2u*)(og + 16 * d) = w2; }
        if (fq == 0) F.L[((size_t)g * MP + row) * 8 + h] = lsum;
    } else {
        const float lt = lsum + la + lb;
        const float il = frcp(lt);
        bf16* gb = F.GA + row * 1536 + 1024 + h * 64 + 4 * fq;
#pragma unroll
        for (int d = 0; d < 4; ++d) { v2u w2;
            w2.x = pk2((o[d][0] + bflo(p1[d].x) + bflo(p2[d].x)) * il * bflo(ag[d].x), (o[d][1] + bfhi(p1[d].x) + bfhi(p2[d].x)) * il * bfhi(ag[d].x));
            w2.y = pk2((o[d][2] + bflo(p1[d].y) + bflo(p2[d].y)) * il * bflo(ag[d].y), (o[d][3] + bfhi(p1[d].y) + bfhi(p2[d].y)) * il * bfhi(ag[d].y));
            *(GAS v2u*)(gb + 16 * d) = w2; }
    }
    __syncthreads();
}
template <bool FINAL> __device__ __forceinline__ void attn_phase(Frame& F, int ubase, int nunits, int nall, int nextra) {
    AttnPre R;
    { LAS f32x4* tb = (LAS f32x4*)(F.lds + 2 * ATT_ROWS * RS_A);
      const GAS f32x4* src = (const GAS f32x4*)(F.TB + TBG_OFF); f32x4 tv[3];
#pragma unroll
      for (int j = 0; j < 3; ++j) { const int i = F.tid + 512 * j; tv[j] = (i < 24 * TBL_STRIDE / 4) ? src[i] : (f32x4){0.f, 0.f, 0.f, 0.f}; }
#pragma unroll
      for (int j = 0; j < 3; ++j) { const int i = F.tid + 512 * j; if (i < 24 * TBL_STRIDE / 4) tb[i] = tv[j]; } }
    if (F.G == 256) {
        const int nk = nall + ((F.vcu >= 128) ? nextra : 0);
#define ATT_UK(k) (ubase + (((k) < nall) ? F.vcu + 256 * (k) : 256 * nall + (F.vcu - 128) + 128 * ((k) - nall)))
        AttnPre R2;
        if (nk > 0) attn_prefetch(F, ATT_UK(0), R);
        if (nk > 1) attn_prefetch(F, ATT_UK(1), R2);
        for (int k = 0; k < nk; k += 2) {
            attn_unit<FINAL>(F, ATT_UK(k), (k + 2 < nk) ? ATT_UK(k + 2) : -1, R);
            if (k + 1 < nk) attn_unit<FINAL>(F, ATT_UK(k + 1), (k + 3 < nk) ? ATT_UK(k + 3) : -1, R2);
        }
#undef ATT_UK
        return;
    }
    int u = F.vcu;
    if (u < nunits) attn_prefetch(F, ubase + u, R);
    for (; u < nunits; u += F.G) { const int un = (u + F.G < nunits) ? ubase + u + F.G : -1; attn_unit<FINAL>(F, ubase + u, un, R); }
}

__device__ __forceinline__ void samp_attn_unit(Frame& F, int u, int zl = 0) {
    const int half = u & 1, i = (u >> 1) & 3, b = u >> 3;
    const int w = F.wave, lane = F.lane + zl, hd = lane >> 3;
    const size_t srow = (size_t)b * ST + i;
    const bf16* pr = F.P + ((size_t)MP + srow) * INW;
    const float* c0 = F.c128; const float* c1 = F.c512; const float* c2 = F.c2048;
    const float* n0 = F.out + O_KVS0; const float* n1 = F.out + O_KVS1; const float* n2 = F.out + O_KVS2;
    f32x4 q[3][2];
#pragma unroll
    for (int g = 0; g < 3; ++g) { const v4u qw = *(const GAS v4u*)(F.APL + ((size_t)(g * 8 + hd) * MPAD + MP + srow) * 64 + (lane & 7) * 8);
        q[g][0] = (f32x4){bflo(qw.x), bfhi(qw.x), bflo(qw.y), bfhi(qw.y)}; q[g][1] = (f32x4){bflo(qw.z), bfhi(qw.z), bflo(qw.w), bfhi(qw.w)}; }
    f32x4 o0 = (f32x4){0.f, 0.f, 0.f, 0.f}, o1 = o0; float l = 0.f;
#pragma unroll 4
    for (int it = 0; it < 25; ++it) {
        const int pidx = half + 2 * w + 16 * it; const bool ok = pidx < 387; const int pc = ok ? pidx : 386;
        const int g = (pc >= 258) ? 2 : (pc >= 129 ? 1 : 0), m = pc - 129 * g;
        const int W = (g == 0) ? 128 : (g == 1 ? 512 : 2048), dil = (g == 0) ? 1 : (g == 1 ? 4 : 16);
        const int e = W + i - dil * m;
        const float* cg = (g == 0) ? c0 : (g == 1 ? c1 : c2); const float* ng = (g == 0) ? n0 : (g == 1 ? n1 : n2);
        const float* kr = ((e < W) ? cg + ((size_t)(b * W + e) * 2) * 512 : ng + ((size_t)(b * ST + (e - W)) * 2) * 512) + lane * 8;
        const f32x4 k0 = __builtin_nontemporal_load((const GAS f32x4*)kr), k1 = __builtin_nontemporal_load((const GAS f32x4*)(kr + 4)), v0 = __builtin_nontemporal_load((const GAS f32x4*)(kr + 512)), v1 = __builtin_nontemporal_load((const GAS f32x4*)(kr + 516));
        const float tbv = F.TB[(g * 8 + hd) * TB_STRIDE + m];
        const f32x4 qa = (g == 0) ? q[0][0] : (g == 1 ? q[1][0] : q[2][0]), qb = (g == 0) ? q[0][1] : (g == 1 ? q[1][1] : q[2][1]);
        float d = ((k0.x * qa.x + k0.y * qa.y) + (k0.z * qa.z + k0.w * qa.w)) + ((k1.x * qb.x + k1.y * qb.y) + (k1.z * qb.z + k1.w * qb.w));
        d += __shfl_xor(d, 1); d += __shfl_xor(d, 2); d += __shfl_xor(d, 4);
        const float p = ok ? __builtin_amdgcn_exp2f(d + tbv) : 0.f;
        o0 += v0 * p; o1 += v1 * p; l += p;
    }
    LAS float* xb = (LAS float*)F.lds;
    { LAS float* x = xb + (w * 64 + lane) * 9; x[0] = o0[0]; x[1] = o0[1]; x[2] = o0[2]; x[3] = o0[3]; x[4] = o1[0]; x[5] = o1[1]; x[6] = o1[2]; x[7] = o1[3]; x[8] = l; }
    __syncthreads();
    if (w == 0) { float s[9];
#pragma unroll
        for (int e = 0; e < 9; ++e) s[e] = 0.f;
#pragma unroll
        for (int ww = 0; ww < 8; ++ww) { const LAS float* x = xb + (ww * 64 + lane) * 9;
#pragma unroll
            for (int e = 0; e < 9; ++e) s[e] += x[e]; }
        float* og = F.OGS + ((size_t)half * MS + srow) * 512 + lane * 8;
        *(GAS f32x4*)og = (f32x4){s[0], s[1], s[2], s[3]}; *(GAS f32x4*)(og + 4) = (f32x4){s[4], s[5], s[6], s[7]};
        if ((lane & 7) == 0) F.LS[((size_t)half * MS + srow) * 8 + hd] = s[8]; }
    __syncthreads();
}

__device__ __forceinline__ void samp_ret_unit(Frame& F, int u) {
    const int b = u >> 2, h = u & 3, tid = F.tid;
    LAS float* qs = (LAS float*)F.lds;
    LAS float* ksm = qs + 512;
    LAS float* vsm = ksm + 512;
    LAS float* sc = vsm + 1024;
    LAS float* red = sc + 16;
    LAS float* st = red + 2048;
    const size_t row0 = (size_t)MP + b * ST;
    const float gam = 1.0f - exp2f(-5.0f - (float)h);
    { const int i = tid >> 7, d = tid & 127; const bf16* pr = F.P + (row0 + i) * INW; qs[tid] = bf2f(pr[C_RQ + h * 128 + d]); ksm[tid] = bf2f(pr[C_RK + h * 128 + d]); }
    for (int e = tid; e < 1024; e += 512) { const int i = e >> 8, d = e & 255; vsm[e] = bf2f(F.P[(row0 + i) * INW + C_RV + h * 256 + d]); }
    __syncthreads();
    if (tid < 16) { const int i = tid >> 2, j = tid & 3; float s = 0.f; for (int d = 0; d < 128; ++d) s += qs[i * 128 + d] * ksm[j * 128 + d]; sc[tid] = (j <= i) ? s * powf(gam, (float)(i - j)) : 0.f; }
    const int dv = tid & 255, half = tid >> 8;
    const float g1 = gam, g2 = gam * gam, g3 = g2 * gam, g4 = g2 * g2;
    float acc[4] = {0.f, 0.f, 0.f, 0.f};
    const float v0 = vsm[dv], v1 = vsm[256 + dv], v2 = vsm[512 + dv], v3 = vsm[768 + dv];
    const float* s0p = F.state + ((size_t)(b * 4 + h) * 128) * 256 + dv; float* snp = F.out + O_RSS + ((size_t)(b * 4 + h) * 128) * 256 + dv;
#pragma unroll 1
    for (int k0 = 0; k0 < 64; k0 += 16) { float sv[16];
#pragma unroll
        for (int k = 0; k < 16; ++k) sv[k] = __builtin_nontemporal_load(s0p + (size_t)(half * 64 + k0 + k) * 256);
#pragma unroll
        for (int k = 0; k < 16; ++k) { const int dk = half * 64 + k0 + k; const float s0 = sv[k];
            acc[0] += qs[dk] * s0; acc[1] += qs[128 + dk] * s0; acc[2] += qs[256 + dk] * s0; acc[3] += qs[384 + dk] * s0;
            __builtin_nontemporal_store(g4 * s0 + g3 * ksm[dk] * v0 + g2 * ksm[128 + dk] * v1 + g1 * ksm[256 + dk] * v2 + ksm[384 + dk] * v3, snp + (size_t)dk * 256); } }
#pragma unroll
    for (int i = 0; i < 4; ++i) red[(half * 4 + i) * 256 + dv] = acc[i];
    __syncthreads();
    float ov[2];
#pragma unroll
    for (int ii = 0; ii < 2; ++ii) { const int i = 2 * half + ii; float o = powf(gam, (float)(i + 1)) * (red[i * 256 + dv] + red[(4 + i) * 256 + dv]);
        o += sc[i * 4 + 0] * v0 + sc[i * 4 + 1] * v1 + sc[i * 4 + 2] * v2 + sc[i * 4 + 3] * v3; ov[ii] = o; }
    const int wv = F.wave;
    { const float s0 = wave_sum(ov[0]), s1 = wave_sum(ov[1]); if (F.lane == 0) { st[wv * 4 + 0] = s0; st[wv * 4 + 1] = s1; } }
    __syncthreads();
    const int wb = half * 4;
    const float mean0 = (st[(wb + 0) * 4 + 0] + st[(wb + 1) * 4 + 0] + st[(wb + 2) * 4 + 0] + st[(wb + 3) * 4 + 0]) * (1.f / 256.f);
    const float mean1 = (st[(wb + 0) * 4 + 1] + st[(wb + 1) * 4 + 1] + st[(wb + 2) * 4 + 1] + st[(wb + 3) * 4 + 1]) * (1.f / 256.f);
    const float d0 = ov[0] - mean0, d1 = ov[1] - mean1;
    { const float s0 = wave_sum(d0 * d0), s1 = wave_sum(d1 * d1); if (F.lane == 0) { st[wv * 4 + 2] = s0; st[wv * 4 + 3] = s1; } }
    __syncthreads();
    const float var0 = (st[(wb + 0) * 4 + 2] + st[(wb + 1) * 4 + 2] + st[(wb + 2) * 4 + 2] + st[(wb + 3) * 4 + 2]) * (1.f / 256.f);
    const float var1 = (st[(wb + 0) * 4 + 3] + st[(wb + 1) * 4 + 3] + st[(wb + 2) * 4 + 3] + st[(wb + 3) * 4 + 3]) * (1.f / 256.f);
    const float gn = F.ret_norm[h * 256 + dv];
#pragma unroll
    for (int ii = 0; ii < 2; ++ii) { const int i = 2 * half + ii; const float y = (ii == 0 ? d0 : d1) * (1.0f / sqrtf((ii == 0 ? var0 : var1) + EPSF)) * gn;
        const float rg = bf2f(F.P[(row0 + i) * INW + C_RG + h * 256 + dv]);
        F.GA[(row0 + i) * 1536 + h * 256 + dv] = (bf16)f2bf(rg * y); }
    __syncthreads();
}

__device__ __forceinline__ void p4_scan_combine(Frame& F) {
    const int gt = blockIdx.x * (NWAVES * 64) + F.tid, NGT = F.G * NWAVES * 64;
    for (int e2 = gt; e2 < 8 * 16384; e2 += NGT) {
        const int bh = e2 >> 14, idx = (e2 & 16383) * 2, h = bh & 3;
        const float gam = 1.0f - exp2f(-5.0f - (float)h); const float cd = powf(gam, 128.0f);
        const bf16* kv = F.KV + (size_t)bh * 64 * 32768 + idx; bf16* sc = F.SC + (size_t)bh * 64 * 32768 + idx;
        float s0 = 0.f, s1 = 0.f;
#pragma unroll 1
        for (int c0 = 0; c0 < NCH; c0 += 16) { unsigned kq[16];
#pragma unroll
            for (int c = 0; c < 16; ++c) kq[c] = *(const GAS unsigned*)(kv + (size_t)(c0 + c) * 32768);
#pragma unroll
            for (int c = 0; c < 16; ++c) { *(GAS unsigned*)(sc + (size_t)(c0 + c) * 32768) = pk2(s0, s1); s0 = s0 * cd + bflo(kq[c]); s1 = s1 * cd + bfhi(kq[c]); } }
        const int dv = idx >> 7, dk = idx & 127;
        float* o = F.out + O_RSP + (size_t)bh * 32768; o[(size_t)dk * 256 + dv] = s0; o[(size_t)(dk + 1) * 256 + dv] = s1;
    }
    const int gw = F.vcu * NWAVES + F.wave, NGW = F.G * NWAVES, lane = F.lane;
    for (int s = gw; s < MS; s += NGW) {
        const int hh = lane >> 3; const float il = 1.0f / (F.LS[(size_t)s * 8 + hh] + F.LS[((size_t)MS + s) * 8 + hh]);
        const float* p0 = F.OGS + (size_t)s * 512 + lane * 8; const float* p1 = p0 + (size_t)MS * 512;
        const f32x4 a0 = *(const GAS f32x4*)p0 + *(const GAS f32x4*)p1, a1 = *(const GAS f32x4*)(p0 + 4) + *(const GAS f32x4*)(p1 + 4);
        const size_t r = (size_t)MP + s;
        const v4u agw = *(const GAS v4u*)(F.P + r * INW + C_AG + lane * 8);
        v4u w; w.x = pk2(bflo(agw.x) * a0[0] * il, bfhi(agw.x) * a0[1] * il); w.y = pk2(bflo(agw.y) * a0[2] * il, bfhi(agw.y) * a0[3] * il);
        w.z = pk2(bflo(agw.z) * a1[0] * il, bfhi(agw.z) * a1[1] * il); w.w = pk2(bflo(agw.w) * a1[2] * il, bfhi(agw.w) * a1[3] * il);
        *(GAS v4u*)(F.GA + r * 1536 + 1024 + lane * 8) = w;
    }
}

template <bool MERGE>
__device__ __forceinline__ void samp_micro_unit(Frame& F, int u) {
    const int lane = F.lane, w = F.wave, fr = lane & 15, fq = lane >> 4, tid = F.tid;
    const int rt = u & 7, cs = u >> 3;
    constexpr int K = MERGE ? 1536 : 1024;
    const bf16* Ap = (MERGE ? F.GA : F.MG) + (size_t)(MP + 16 * rt + fr) * K + 8 * fq + 128 * w;
    const bf16* Bp = (MERGE ? F.Wt_pr : F.Wt_out) + (size_t)(32 * cs + fr) * K + 8 * fq + 128 * w;
    v4u af[4], b0[4], b1[4];
#pragma unroll
    for (int s = 0; s < 4; ++s) { af[s] = *(const GAS v4u*)(Ap + 32 * s); b0[s] = *(const GAS v4u*)(Bp + 32 * s); b1[s] = *(const GAS v4u*)(Bp + (size_t)16 * K + 32 * s); }
    v4u ag[2], c0[2], c1[2]; unsigned gw[4]; f32x4 xr;
    if constexpr (MERGE) {
        const bf16* Aq = Ap - 128 * w + 1024 + 64 * w; const bf16* Bq = Bp - 128 * w + 1024 + 64 * w;
#pragma unroll
        for (int s = 0; s < 2; ++s) { ag[s] = *(const GAS v4u*)(Aq + 32 * s); c0[s] = *(const GAS v4u*)(Bq + 32 * s); c1[s] = *(const GAS v4u*)(Bq + (size_t)16 * K + 32 * s); }
        const unsigned char* gp = (const unsigned char*)F.P + (size_t)(MP + 16 * rt + fr) * (INW * 2) + GATE_OFF + 32 * cs + 4 * fq;
        gw[0] = *(const GAS unsigned*)gp; gw[1] = *(const GAS unsigned*)(gp + 16); gw[2] = *(const GAS unsigned*)(gp + 1024); gw[3] = *(const GAS unsigned*)(gp + 1040);
    } else {
        if (tid < 128) xr = *(const GAS f32x4*)(F.xs + (size_t)(16 * rt + fr) * DM + 32 * cs + 16 * (tid >> 6) + 4 * fq);
    }
    f32x4 a0 = (f32x4){0.f, 0.f, 0.f, 0.f}, a1 = a0;
#pragma unroll
    for (int s = 0; s < 4; ++s) { const bf16x8 y = __builtin_bit_cast(bf16x8, af[s]); a0 = MFMA16(__builtin_bit_cast(bf16x8, b0[s]), y, a0); a1 = MFMA16(__builtin_bit_cast(bf16x8, b1[s]), y, a1); }
    if constexpr (MERGE) {
        f32x4 e0 = (f32x4){0.f, 0.f, 0.f, 0.f}, e1 = e0;
#pragma unroll
        for (int s = 0; s < 2; ++s) { const bf16x8 y = __builtin_bit_cast(bf16x8, ag[s]); e0 = MFMA16(__builtin_bit_cast(bf16x8, c0[s]), y, e0); e1 = MFMA16(__builtin_bit_cast(bf16x8, c1[s]), y, e1); }
#pragma unroll
        for (int r = 0; r < 4; ++r) {
            a0[r] = (a0[r] * (float)((gw[0] >> (8 * r)) & 0xffu) + e0[r] * (float)((gw[2] >> (8 * r)) & 0xffu)) * (1.0f / 255.0f);
            a1[r] = (a1[r] * (float)((gw[1] >> (8 * r)) & 0xffu) + e1[r] * (float)((gw[3] >> (8 * r)) & 0xffu)) * (1.0f / 255.0f); }
    }
    LAS unsigned char* red = F.lds;
    *(LAS f32x4*)(red + ((w * 2 + 0) * 64 + lane) * 16) = a0;
    *(LAS f32x4*)(red + ((w * 2 + 1) * 64 + lane) * 16) = a1;
    __syncthreads();
    if (tid < 128) {
        const int t = tid >> 6;
        f32x4 sm = *(const LAS f32x4*)(red + (t * 64 + lane) * 16);
#pragma unroll
        for (int ww = 1; ww < 8; ++ww) sm += *(const LAS f32x4*)(red + ((ww * 2 + t) * 64 + lane) * 16);
        const size_t o = (size_t)(MP + 16 * rt + fr) * DM + 32 * cs + 16 * t + 4 * fq;
        if constexpr (MERGE) { v2u y; y.x = pk2(sm[0], sm[1]); y.y = pk2(sm[2], sm[3]); *(GAS v2u*)(F.MG + o) = y; }
        else { *(GAS f32x4*)(F.out + o) = xr + sm; }
    }
    __syncthreads();
}

__device__ __forceinline__ void ret_out_unit(Frame& F, int u) {
    const int c = u & 63, h = (u >> 6) & 3, b = u >> 8;
    const int tid = F.tid, lane = F.lane, w = F.wave, fr = lane & 15, fq = lane >> 4;
    LAS unsigned char* ks = F.lds; LAS unsigned char* vs = F.lds + 128 * RS_K; LAS unsigned char* s0 = vs + 128 * RS_V;
    const size_t row0 = (size_t)b * TP + c * 128;
    const bf16* Pr = F.P + row0 * INW;
    const bf16* scg = F.SC + (size_t)u * 32768;
    const float l2g = head_log2g(h);
    v4u s1r[4];
    { v4u kx[4], s0x[4], vx[8];
#pragma unroll
      for (int it = 0; it < 4; ++it) { const int id = tid + 512 * it, row = id >> 4, ch = id & 15;
        kx[it] = *(const GAS v4u*)(Pr + (size_t)row * INW + C_RK + h * 128 + ch * 8); s0x[it] = *(const GAS v4u*)(scg + (size_t)row * 128 + ch * 8); s1r[it] = *(const GAS v4u*)(scg + (size_t)(128 + row) * 128 + ch * 8); }
#pragma unroll
      for (int it = 0; it < 8; ++it) { const int id = tid + 512 * it, row = id >> 5, ch = id & 31; vx[it] = *(const GAS v4u*)(Pr + (size_t)row * INW + C_RV + h * 256 + ch * 8); }
#pragma unroll
      for (int it = 0; it < 4; ++it) { const int id = tid + 512 * it, row = id >> 4, ch = id & 15; *(LAS v4u*)(ks + row * RS_K + ch * 16) = kx[it]; *(LAS v4u*)(s0 + row * RS_K + ch * 16) = s0x[it]; }
#pragma unroll
      for (int it = 0; it < 8; ++it) { const int id = tid + 512 * it, row = id >> 5, ch = id & 31; *(LAS v4u*)(vs + row * RS_V + ch * 16) = vx[it]; } }
    const int tq = 16 * w + fr;
    const bf16* qp = Pr + (size_t)tq * INW + C_RQ + h * 128 + 8 * fq;
    bf16x8 qf[4], qd[4];
    const float qdec = fexp2((float)(tq + 1) * l2g);
#pragma unroll
    for (int s = 0; s < 4; ++s) { const v4u x = *(const GAS v4u*)(qp + 32 * s); qf[s] = __builtin_bit_cast(bf16x8, x);
        v4u y; y.x = pk2(bflo(x.x) * qdec, bfhi(x.x) * qdec); y.y = pk2(bflo(x.y) * qdec, bfhi(x.y) * qdec); y.z = pk2(bflo(x.z) * qdec, bfhi(x.z) * qdec); y.w = pk2(bflo(x.w) * qdec, bfhi(x.w) * qdec);
        qd[s] = __builtin_bit_cast(bf16x8, y); }
    __syncthreads();
    f32x4 pt[8];
#pragma unroll
    for (int n = 0; n < 8; ++n) {
        f32x4 sa = (f32x4){0.f, 0.f, 0.f, 0.f};
        if (n <= w) {
            const LAS unsigned char* ka = ks + (16 * n + fr) * RS_K + 16 * fq;
            bf16x8 kf[4];
#pragma unroll
            for (int kk = 0; kk < 4; ++kk) kf[kk] = *(const LAS bf16x8*)(ka + 64 * kk);
#pragma unroll
            for (int kk = 0; kk < 4; ++kk) sa = MFMA16(kf[kk], qf[kk], sa);
#pragma unroll
            for (int e = 0; e < 4; ++e) { const int diff = tq - (16 * n + 4 * fq + e); sa[e] = (diff >= 0) ? sa[e] * fexp2((float)diff * l2g) : 0.f; }
        }
        pt[n] = sa;
    }
    __syncthreads();
#pragma unroll
    for (int it = 0; it < 4; ++it) { const int id = tid + 512 * it, row = id >> 4, ch = id & 15; *(LAS v4u*)(ks + row * RS_K + ch * 16) = s1r[it]; }
    f32x4 o[16];
#pragma unroll
    for (int d = 0; d < 16; ++d) o[d] = (f32x4){0.f, 0.f, 0.f, 0.f};
    const int q4 = (lane & 15) >> 2, p4 = lane & 3;
#pragma unroll
    for (int st = 0; st < 4; ++st) {
        if (2 * st <= w) {
            const bf16x8 pf = pack8(pt[2 * st][0], pt[2 * st][1], pt[2 * st][2], pt[2 * st][3], pt[2 * st + 1][0], pt[2 * st + 1][1], pt[2 * st + 1][2], pt[2 * st + 1][3]);
            const LAS unsigned char* va = vs + (32 * st + 4 * fq + q4) * RS_V + 8 * p4;
#pragma unroll
            for (int d0 = 0; d0 < 16; d0 += 4) { s16x4 va_[4], vb_[4];
#pragma unroll
                for (int d = 0; d < 4; ++d) { va_[d] = vtr(va + 32 * (d0 + d)); vb_[d] = vtr(va + 16 * RS_V + 32 * (d0 + d)); }
#pragma unroll
                for (int d = 0; d < 4; ++d) o[d0 + d] = MFMA16(cat8(va_[d], vb_[d]), pf, o[d0 + d]); }
        }
    }
    __syncthreads();
#pragma unroll
    for (int d0 = 0; d0 < 16; d0 += 2) { bf16x8 sf[2][4];
#pragma unroll
        for (int d = 0; d < 2; ++d) { const LAS unsigned char* sa = ((d0 + d < 8) ? s0 : ks) + (16 * ((d0 + d) & 7) + fr) * RS_K + 16 * fq;
#pragma unroll
            for (int s = 0; s < 4; ++s) sf[d][s] = *(const LAS bf16x8*)(sa + 64 * s); }
#pragma unroll
        for (int d = 0; d < 2; ++d)
#pragma unroll
            for (int s = 0; s < 4; ++s) o[d0 + d] = MFMA16(sf[d][s], qd[s], o[d0 + d]); }
    float sm = 0.f;
#pragma unroll
    for (int d = 0; d < 16; ++d) sm += (o[d][0] + o[d][1]) + (o[d][2] + o[d][3]);
    sm += __shfl_xor(sm, 16); sm += __shfl_xor(sm, 32);
    const float mean = sm * (1.f / 256.f); float vq = 0.f;
#pragma unroll
    for (int d = 0; d < 16; ++d) { o[d] = o[d] - mean; vq += (o[d][0] * o[d][0] + o[d][1] * o[d][1]) + (o[d][2] * o[d][2] + o[d][3] * o[d][3]); }
    vq += __shfl_xor(vq, 16); vq += __shfl_xor(vq, 32);
    const float rstd = frsq(vq * (1.f / 256.f) + EPSF);
    const bf16* rgp = Pr + (size_t)tq * INW + C_RG + h * 256 + 4 * fq; const float* gnp = F.ret_norm + h * 256 + 4 * fq;
    bf16* gap = F.GA + (row0 + tq) * 1536 + h * 256 + 4 * fq;
#pragma unroll
    for (int hf = 0; hf < 2; ++hf) { v2u rgv[8]; f32x4 gnv[8];
#pragma unroll
        for (int d = 0; d < 8; ++d) { rgv[d] = *(const GAS v2u*)(rgp + 16 * (8 * hf + d)); gnv[d] = *(const GAS f32x4*)(gnp + 16 * (8 * hf + d)); }
#pragma unroll
        for (int d8 = 0; d8 < 8; ++d8) { const int d = 8 * hf + d8; const v2u rg = rgv[d8]; const f32x4 gn = gnv[d8];
            v2u y; y.x = pk2(o[d][0] * rstd * gn.x * bflo(rg.x), o[d][1] * rstd * gn.y * bfhi(rg.x));
            y.y = pk2(o[d][2] * rstd * gn.z * bflo(rg.y), o[d][3] * rstd * gn.w * bfhi(rg.y));
            *(GAS v2u*)(gap + 16 * d) = y; } }
    __syncthreads();
}
#ifndef MK_N_LAUNCHES
#define MK_N_LAUNCHES 1
#endif
constexpr int N_PHASES = 9;
#ifndef REP_PHASE
#define REP_PHASE -1
#endif
struct Args { const float* in[15]; float* out; unsigned char* ws; int ph_lo, ph_hi, use_bar, pad; };
__global__ void __launch_bounds__(NWAVES * 64, 2) mk_fwd(Args args) {
    extern __shared__ __attribute__((aligned(16))) unsigned char lds[];
    Frame F;
    F.lds = (LAS unsigned char*)lds;
    F.MISC = (volatile LAS unsigned*)(F.lds + MISC_OFF);
    F.tid = threadIdx.x; F.lane = F.tid & 63; F.wave = __builtin_amdgcn_readfirstlane(F.tid >> 6);
    F.G = gridDim.x; { const int bx = blockIdx.x; F.vcu = (F.G % 8 == 0) ? (bx % 8) * (F.G / 8) + bx / 8 : bx; }
    unsigned char* ws = args.ws;
    F.ctl = (gu32*)(ws + WS_CTL);
    F.xp = args.in[0]; F.xs = args.in[1]; F.c128 = args.in[2]; F.c512 = args.in[3]; F.c2048 = args.in[4]; F.state = args.in[5]; F.w_norm = args.in[6]; F.w_in = args.in[7];
    F.q_norm = args.in[8]; F.k_norm = args.in[9]; F.rel_bias = args.in[10]; F.ret_norm = args.in[11]; F.w_pr = args.in[12]; F.w_pa = args.in[13]; F.w_out = args.in[14];
    F.out = args.out;
    F.Wt_in = (bf16*)(ws + WS_WIN); F.Wt_pr = (bf16*)(ws + WS_WPR); F.Wt_pa = (bf16*)(ws + WS_WPA); F.Wt_out = (bf16*)(ws + WS_WOUT);
    F.XB = (bf16*)(ws + WS_XB); F.P = (bf16*)(ws + WS_P); F.SC = (bf16*)(ws + WS_SC); F.GA = (bf16*)(ws + WS_GA); F.GB = (bf16*)(ws + WS_GB); F.MG = (bf16*)(ws + WS_MG); F.APL = (bf16*)(ws + WS_APL);
    F.TB = (float*)(ws + WS_TB); F.KV = (bf16*)(ws + WS_KV); F.OGS = (float*)(ws + WS_OGS); F.LS = (float*)(ws + WS_LS); F.OG = (bf16*)(ws + WS_OG); F.L = (float*)(ws + WS_L); F.ROPE = (f32x2*)(ws + WS_ROPE);
    for (int u = F.tid; u < (LDS_BYTES - LDSCTL_OFF) / 4; u += NWAVES * 64) ((LAS unsigned*)(F.lds + LDSCTL_OFF))[u] = 0u;
    __syncthreads();
    XcdBarrier bar; bar.bar = (unsigned*)(F.ctl + CW_BAR); bar.x = 0; bar.st = nullptr;
    if (args.use_bar) bar = xcd_barrier_post((unsigned*)(F.ctl + CW_BAR), F.MISC + 8);
    const int lo = args.ph_lo, hi = args.ph_hi;
#define IN(k) (lo <= (k) && (k) < hi)
#if REP_PHASE == 99
#define SEAM(k) do { if (IN(k) && ((k) + 1 < hi)) { xcd_barrier(bar); xcd_barrier(bar); } } while (0)
#else
#define SEAM(k) do { if (IN(k) && ((k) + 1 < hi)) xcd_barrier(bar); } while (0)
#endif

#ifndef P1_ROT
#define P1_ROT 8
#endif
#ifndef P1_ALIGN
#define P1_ALIGN true
#endif
#define PH1() do { { LAS float* gl = (LAS float*)(F.lds + GAINS_OFF); if (F.tid < 64) gl[F.tid] = F.q_norm[F.tid] * (0.125f * 1.4426950408889634f); else if (F.tid < 128) gl[F.tid] = F.k_norm[F.tid - 64]; __syncthreads(); } \
        pg8::EpiInProj E{F.P, F.out, (const pg8::f32x4*)F.ROPE, F.APL}; \
        for (int u = blockIdx.x; u < INW / 64; u += F.G) pg8::gemm128_direct<DM, pg8::EpiInProj>(F.lds, F.XB + (size_t)MP * DM, F.Wt_in, MP / 256, u, E); \
        if (F.G > INW / 64) { if ((int)blockIdx.x >= INW / 64) p1_late_weights(F, (int)blockIdx.x - INW / 64, F.G - INW / 64); } else p1_late_weights(F, (int)blockIdx.x, F.G); \
        pg8::Gemm g{F.XB, F.Wt_in, MP, INW, DM}; pg8::StaticOrder S; S.init(MP, INW, F.G, (int)blockIdx.x, P1_ROT);     \
        pg8::gemm_phase<pg8::EpiInProj, pg8::StaticOrder, P1_ALIGN, true>(F.lds + RING_OFF, g, S, E); } while (0)
#define PH3() do { for (int u = F.vcu; u < 128; u += F.G) samp_ret_unit(F, u); \
        for (int u = F.vcu; u < 256; u += F.G) samp_attn_unit(F, u); \
        for (int u = blockIdx.x; u < 512; u += F.G) ret_kv_unit(F, u); \
        attn_phase<false>(F, 1024, 2048, 7, 2); } while (0)
#define PH5() do { for (int u = blockIdx.x; u < 512; u += F.G) ret_out_unit(F, u); } while (0)
#define PH6() do { pg8::EpiMerge E{F.MG, DM, (const unsigned char*)F.P + GATE_OFF, (size_t)INW * 2, MR}; \
        for (int u = blockIdx.x; u < 256; u += F.G) samp_micro_unit<true>(F, u); \
        pg8::Gemm g{F.GA, F.Wt_pr, MP, DM, 1536}; pg8::StaticOrder S; S.init(MP, DM, F.G, (int)blockIdx.x); \
        pg8::gemm_phase<pg8::EpiMerge, pg8::StaticOrder, true, true>(F.lds + RING_OFF, g, S, E); } while (0)
#define PH7() do { } while (0)
#define PH8() do { pg8::EpiResidual E{F.xp, F.xs, F.out, DM, MP, MR}; \
        for (int u = blockIdx.x; u < 256; u += F.G) samp_micro_unit<false>(F, u); \
        pg8::Gemm g{F.MG, F.Wt_out, MP, DM, DM}; pg8::StaticOrder S; S.init(MP, DM, F.G, (int)blockIdx.x); \
        pg8::gemm_phase<pg8::EpiResidual, pg8::StaticOrder, true, true>(F.lds + RING_OFF, g, S, E); } while (0)
#define PH6_8() do { PH6(); \
        pg8::f32x4 xacc[2][2][4][2]; \
        { pg8::EpiResidual E7{F.xp, F.xs, F.out, DM, MP, MR}; pg8::StaticOrder S7; S7.init(MP, DM, F.G, (int)blockIdx.x); pg8::Unit u7; S7.next(0, u7); \
          E7.init(xacc, u7, F.wave >> 2, F.wave & 3, F.lane & 15, F.lane >> 4); } \
        xcd_barrier(bar); \
        { pg8::EpiResidual E8{F.xp, F.xs, F.out, DM, MP, MR}; pg8::StaticOrder S8; S8.init(MP, DM, F.G, (int)blockIdx.x); pg8::Gemm g8{F.MG, F.Wt_out, MP, DM, DM}; \
          pg8::gemm_phase<pg8::EpiResidual, pg8::StaticOrder, true, true, true>(F.lds + RING_OFF, g8, S8, E8, xacc); \
          for (int u = blockIdx.x; u < 16; u += F.G) pg8::gemm128_direct<DM, pg8::EpiResidual>(F.lds, F.MG + (size_t)MP * DM, F.Wt_out, MP / 256, u, E8); } } while (0)
    if (IN(0)) { p0_prologue(F);
#if REP_PHASE == 0
        p0_prologue(F);
#endif
    } SEAM(0);
#if MK_N_LAUNCHES == 1 && REP_PHASE == -1
    if (IN(1)) {   LAS float* gl = (LAS float*)(F.lds + GAINS_OFF); if (F.tid < 64) gl[F.tid] = F.q_norm[F.tid] * (0.125f * 1.4426950408889634f); else if (F.tid < 128) gl[F.tid] = F.k_norm[F.tid - 64]; __syncthreads();
        pg8::EpiInProj E{F.P, F.out, (const pg8::f32x4*)F.ROPE, F.APL};
        for (int u = blockIdx.x; u < INW / 64; u += F.G) pg8::gemm128_direct<DM, pg8::EpiInProj>(F.lds, F.XB + (size_t)MP * DM, F.Wt_in, MP / 256, u, E);
        if (F.G > INW / 64) { if ((int)blockIdx.x >= INW / 64) p1_late_weights(F, (int)blockIdx.x - INW / 64, F.G - INW / 64); } else p1_late_weights(F, (int)blockIdx.x, F.G);
        xcd_split_arrive(bar, 0);
        pg8::Gemm g{F.XB, F.Wt_in, MP, INW, DM}; pg8::StaticOrder S; S.init(MP, INW, F.G, (int)blockIdx.x, P1_ROT);
        pg8::gemm_phase<pg8::EpiInProj, pg8::StaticOrder, P1_ALIGN, true>(F.lds + RING_OFF, g, S, E); }
    if (IN(3)) {
    xcd_split_arrive(bar, 1);
    xcd_split_wait(bar, 0);
    for (int u = F.vcu; u < 256; u += F.G) samp_attn_unit(F, u);
    for (int u = F.vcu; u < 128; u += F.G) samp_ret_unit(F, u);
    xcd_split_wait(bar, 1);
    for (int u = blockIdx.x; u < 512; u += F.G) ret_kv_unit(F, u);
    xcd_split_arrive(bar, 2);
    attn_phase<false>(F, 1024, 2048, 7, 2);
    xcd_split_arrive(bar, 3);
    xcd_split_wait(bar, 2);
    p4_scan_combine(F);
    xcd_split_arrive(bar, 4);
    xcd_split_wait(bar, 3);
    attn_phase<true>(F, 0, 1024, 4, 0);
    xcd_split_wait(bar, 4);
    PH5(); }
    if (IN(6)) {
    xcd_split_arrive(bar, 5);
    for (int u = blockIdx.x; u < 256; u += F.G) samp_micro_unit<true>(F, u);
    xcd_split_arrive(bar, 6);
    xcd_split_wait(bar, 5);
    {   pg8::EpiMerge E{F.MG, DM, (const unsigned char*)F.P + GATE_OFF, (size_t)INW * 2, MR};
        pg8::Gemm g{F.GA, F.Wt_pr, MP, DM, 1536}; pg8::StaticOrder S; S.init(MP, DM, F.G, (int)blockIdx.x);
        pg8::gemm_phase<pg8::EpiMerge, pg8::StaticOrder, true, true>(F.lds + RING_OFF, g, S, E); } }
    if (IN(8)) {
    xcd_split_arrive(bar, 7);
    xcd_split_wait(bar, 6);
    for (int u = blockIdx.x; u < 256; u += F.G) samp_micro_unit<false>(F, u);
    {   pg8::EpiResidual E{F.xp, F.xs, F.out, DM, MP, MR};
        pg8::Gemm g{F.MG, F.Wt_out, MP, DM, DM}; pg8::StaticOrder S; S.init(MP, DM, F.G, (int)blockIdx.x);
        pg8::f32x4 xacc[2][2][4][2];
        { pg8::Unit u0; if (S.next(0, u0)) E.init(xacc, u0, F.wave >> 2, F.wave & 3, F.lane & 15, F.lane >> 4); }
        xcd_split_wait(bar, 7);
        pg8::gemm_phase<pg8::EpiResidual, pg8::StaticOrder, true, true, true>(F.lds + RING_OFF, g, S, E, xacc); } }
#else
    if (IN(1)) {
#if REP_PHASE == 15
        { pg8::EpiPlainLine EN{F.P, INW}; pg8::Gemm g{F.XB, F.Wt_in, MP, INW, DM}; pg8::StaticOrder S; S.init(MP, INW, F.G, (int)blockIdx.x);
          pg8::gemm_phase<pg8::EpiPlainLine, pg8::StaticOrder, true, true, false, true>(F.lds + RING_OFF, g, S, EN); }
#endif
#if REP_PHASE == 14
        { pg8::EpiPlainFull EN{F.P, INW}; pg8::Gemm g{F.XB, F.Wt_in, MP, INW, DM}; pg8::StaticOrder S; S.init(MP, INW, F.G, (int)blockIdx.x);
          pg8::gemm_phase<pg8::EpiPlainFull, pg8::StaticOrder, true, true>(F.lds + RING_OFF, g, S, EN); }
#endif
#if REP_PHASE == 13
        { pg8::EpiPlain EN{F.P, INW, MR}; pg8::Gemm g{F.XB, F.Wt_in, MP, INW, DM}; pg8::StaticOrder S; S.init(MP, INW, F.G, (int)blockIdx.x);
          pg8::gemm_phase<pg8::EpiPlain, pg8::StaticOrder, true, true, false, true>(F.lds + RING_OFF, g, S, EN); }
#endif
#if REP_PHASE == 12
        { pg8::EpiScratch EN{F.MG + (size_t)blockIdx.x * 65536}; pg8::Gemm g{F.XB, F.Wt_in, MP, INW, DM}; pg8::StaticOrder S; S.init(MP, INW, F.G, (int)blockIdx.x);
          pg8::gemm_phase<pg8::EpiScratch, pg8::StaticOrder, true, true>(F.lds + RING_OFF, g, S, EN); }
#endif
#if REP_PHASE == 11
        { pg8::EpiNull EN; pg8::Gemm g{F.XB, F.Wt_in, MP, INW, DM}; pg8::StaticOrder S; S.init(MP, INW, F.G, (int)blockIdx.x);
          pg8::gemm_phase<pg8::EpiNull, pg8::StaticOrder, true, true>(F.lds + RING_OFF, g, S, EN); }
#endif
        PH1();
#if REP_PHASE == 1
        PH1();
#endif
    } SEAM(1);
    if (IN(3)) { PH3();
#if REP_PHASE == 3
        PH3();
#endif
#if REP_PHASE == 31
        attn_phase<false>(F, 1024, 2048, 7, 2);
#endif
#if REP_PHASE == 32
        for (int u = blockIdx.x; u < 128; u += F.G) samp_ret_unit(F, u);
        for (int u = blockIdx.x; u < 256; u += F.G) samp_attn_unit(F, u);
#endif
#if REP_PHASE == 34
        for (int u = F.vcu; u < 256; u += F.G) samp_attn_unit(F, u);
#endif
#if REP_PHASE == 35
        for (int u = F.vcu; u < 128; u += F.G) samp_ret_unit(F, u);
#endif
#if REP_PHASE == 33
        for (int u = blockIdx.x; u < 512; u += F.G) ret_kv_unit(F, u);
#endif
    } SEAM(3);
    if (IN(4)) { p4_scan_combine(F); attn_phase<true>(F, 0, 1024, 4, 0);
#if REP_PHASE == 4
        p4_scan_combine(F); attn_phase<true>(F, 0, 1024, 4, 0);
#endif
#if REP_PHASE == 41
        p4_scan_combine(F);
#endif
#if REP_PHASE == 42
        attn_phase<true>(F, 0, 1024, 4, 0);
#endif
#if REP_PHASE == 43
        attn_phase<false>(F, 0, 1024, 4, 0);
#endif
#if REP_PHASE == 44
        attn_phase<false>(F, 1024, 1024, 4, 0);
#endif
    } SEAM(4);
    if (IN(5)) { PH5();
#if REP_PHASE == 5
        PH5();
#endif
    } SEAM(5);
#if REP_PHASE == 6
    if (IN(6)) { PH6(); } SEAM(6);
    if (IN(8)) { PH8(); } xcd_barrier(bar);
    if (IN(6)) { PH6(); } SEAM(6);
    if (IN(8)) { PH8(); }
#elif REP_PHASE == 81
    if (IN(6)) { PH6(); } SEAM(6);
    if (IN(8)) { PH8(); PH8(); }
#elif REP_PHASE == 63
    if (IN(6)) { { pg8::EpiMerge E{F.MG, DM, (const unsigned char*)F.P + GATE_OFF, (size_t)INW * 2, MR};
        for (int u = blockIdx.x; u < 32; u += F.G) pg8::gemm128_half<1536, 1024, pg8::EpiMerge>(F.lds, F.GA + (size_t)MP * 1536, 1536, F.Wt_pr, 1536, MP / 256, u, E); }
        PH6(); } SEAM(6);
    if (IN(8)) { { pg8::EpiResidual E{F.xp, F.xs, F.out, DM, MP, MR};
        for (int u = blockIdx.x; u < 32; u += F.G) pg8::gemm128_half<DM, 0, pg8::EpiResidual>(F.lds, F.MG + (size_t)MP * DM, DM, F.Wt_out, DM, MP / 256, u, E); }
        PH8(); }
#else
    if (IN(6)) { PH6(); } SEAM(6);
    if (IN(8)) { PH8(); }
#endif
#endif
#undef IN
#undef SEAM
}

extern "C" void kernel_launch(void* const* d_in, const int* in_sizes, int n_in, void* d_out, int out_size, void* d_ws, size_t ws_size, hipStream_t stream) {
    static int grid = 0;
    if (grid == 0) {
        if (n_in != 15 || (size_t)out_size != O_END || ws_size < WS_END) { fprintf(stderr, "kernel_launch: unexpected shapes: n_in %d out %d ws %zu\n", n_in, out_size, ws_size); grid = -1; return; }
        int dev = 0, cus = 0;
        if (hipGetDevice(&dev) != hipSuccess || hipDeviceGetAttribute(&cus, hipDeviceAttributeMultiprocessorCount, dev) != hipSuccess) { grid = -1; return; }
        if (hipFuncSetAttribute((const void*)mk_fwd, hipFuncAttributeMaxDynamicSharedMemorySize, LDS_BYTES) != hipSuccess) { fprintf(stderr, "kernel_launch: hipFuncSetAttribute failed\n"); grid = -1; return; }
        int per_cu = 0;
        if (hipOccupancyMaxActiveBlocksPerMultiprocessor(&per_cu, (const void*)mk_fwd, NWAVES * 64, LDS_BYTES) != hipSuccess || per_cu < 1) fprintf(stderr, "kernel_launch: occupancy query says %d per CU\n", per_cu);
        (void)hipGetLastError();
        grid = cus;
    }
    if (grid < 0) return;
    if (hipMemsetAsync((char*)d_ws + WS_CTL, 0, CTL_ZERO_BYTES, stream) != hipSuccess) return;
    Args a{};
    for (int i = 0; i < 15; ++i) a.in[i] = (const float*)d_in[i];
    a.out = (float*)d_out; a.ws = (unsigned char*)d_ws;
    if (MK_N_LAUNCHES == 1) { a.ph_lo = 0; a.ph_hi = N_PHASES; a.use_bar = 1; hipLaunchKernelGGL(mk_fwd, dim3(grid), dim3(NWAVES * 64), LDS_BYTES, stream, a); }
    else { for (int p = 0; p < N_PHASES; ++p) { a.ph_lo = p; a.ph_hi = p + 1; a.use_bar = 0; hipLaunchKernelGGL(mk_fwd, dim3(grid), dim3(NWAVES * 64), LDS_BYTES, stream, a); } }
}
```

```cpp
#include <hip/hip_runtime.h>
#include <cstdio>
#include <cstdint>
#include <cmath>
constexpr int NWAVES = 8;
constexpr int DM = 1024, NB = 2, TP = 8192, MP = NB * TP;
constexpr int SB = 32, ST = 4, MS = SB * ST;
constexpr int MR = MP + MS, MPAD = 16640;
constexpr int INW = 10240;
constexpr int C_RQ = 0, C_RK = 512, C_RV = 1024, C_RG = 2048, C_AQ = 3072, C_AK = 4608, C_AV = 6144, C_AG = 7680, C_GA = 8192, C_GB = 9216;
constexpr int GATE_OFF = C_GA * 2;
constexpr int NCH = TP / 128;
constexpr float EPSF = 1e-6f;
constexpr size_t O_YP = 0, O_YS = O_YP + (size_t)MP * DM, O_RSP = O_YS + (size_t)MS * DM, O_RSS = O_RSP + (size_t)NB * 4 * 128 * 256,
                 O_KVP0 = O_RSS + (size_t)SB * 4 * 128 * 256, O_KVP1 = O_KVP0 + (size_t)NB * 128 * 1024, O_KVP2 = O_KVP1 + (size_t)NB * 512 * 1024,
                 O_KVS0 = O_KVP2 + (size_t)NB * 2048 * 1024, O_KVS1 = O_KVS0 + (size_t)MS * 1024, O_KVS2 = O_KVS1 + (size_t)MS * 1024, O_END = O_KVS2 + (size_t)MS * 1024;
constexpr size_t MiB = 1u << 20;
constexpr size_t WS_CTL = 0, CTL_ZERO_BYTES = 131072;
constexpr size_t WS_TB = 1 * MiB;
constexpr int TB_STRIDE = 136, TB_C = 4000;
constexpr int TBL_STRIDE = 176, TBG_OFF = 8192;
constexpr size_t WS_ROPE = 2 * MiB;
constexpr size_t WS_WIN = 8 * MiB, WS_WPR = 28 * MiB, WS_WPA = 30 * MiB, WS_WOUT = 31 * MiB;
constexpr size_t WS_XB = 34 * MiB;
constexpr size_t WS_P = 68 * MiB;
constexpr size_t WS_KV = 394 * MiB;
constexpr size_t WS_SC = 458 * MiB;
constexpr size_t WS_GA = 490 * MiB;
constexpr size_t WS_GB = 523 * MiB;
constexpr size_t WS_MG = 540 * MiB;
constexpr size_t WS_OG = 573 * MiB;
constexpr size_t WS_L = 669 * MiB;
constexpr size_t WS_OGS = 671 * MiB;
constexpr size_t WS_LS = WS_OGS + 768 * 1024;
constexpr size_t WS_END = 672 * MiB;
constexpr int CW_TMO = 0, CW_CODE = 1, CW_BAR = 4096;
constexpr int LDS_BYTES = 147456;
constexpr int LDSCTL_OFF = 146944, MISC_OFF = LDSCTL_OFF + 320;
constexpr int RING_OFF = 0;
constexpr int GAINS_OFF = 146432;

#define GAS __attribute__((address_space(1)))
#define LAS __attribute__((address_space(3)))
typedef unsigned short bf16;
typedef unsigned v4u __attribute__((ext_vector_type(4)));
typedef unsigned v2u __attribute__((ext_vector_type(2)));
typedef float f32x4 __attribute__((ext_vector_type(4)));
typedef float f32x2 __attribute__((ext_vector_type(2)));
typedef short bf16x8 __attribute__((ext_vector_type(8)));
typedef short s16x4 __attribute__((ext_vector_type(4)));
typedef GAS unsigned gu32;
#define RLX_AGENT __ATOMIC_RELAXED, __HIP_MEMORY_SCOPE_AGENT
#define LDS_WAIT() asm volatile("s_waitcnt lgkmcnt(0)" ::: "memory")
#define VM_WAIT() asm volatile("s_waitcnt vmcnt(0)" ::: "memory")
__device__ __forceinline__ unsigned f2bf(float f) { unsigned u = __builtin_bit_cast(unsigned, f); return (u + 0x7fffu + ((u >> 16) & 1u)) >> 16; }
typedef __bf16 bf16x2_t __attribute__((ext_vector_type(2)));
__device__ __forceinline__ unsigned pk2(float lo, float hi) { f32x2 v = {lo, hi}; bf16x2_t b = __builtin_convertvector(v, bf16x2_t); return __builtin_bit_cast(unsigned, b); }
__device__ __forceinline__ float bf2f(unsigned short h) { return __uint_as_float((unsigned)h << 16); }
__device__ __forceinline__ float bflo(unsigned w) { return __uint_as_float(w << 16); }
__device__ __forceinline__ float bfhi(unsigned w) { return __uint_as_float(w & 0xffff0000u); }
__device__ __forceinline__ float fexp2(float x) { return __builtin_amdgcn_exp2f(x); }
__device__ __forceinline__ float frcp(float x) { return __builtin_amdgcn_rcpf(x); }
__device__ __forceinline__ float frsq(float x) { return __builtin_amdgcn_rsqf(x); }
__device__ __forceinline__ float silu_f(float x) { return x * frcp(1.0f + fexp2(-1.4426950408889634f * x)); }
#define MFMA16(a, b, c) __builtin_amdgcn_mfma_f32_16x16x32_bf16((a), (b), (c), 0, 0, 0)
typedef short v4i16_t __attribute__((ext_vector_type(4)));
__device__ __forceinline__ s16x4 vtr(const LAS unsigned char* p) { return __builtin_bit_cast(s16x4, __builtin_amdgcn_ds_read_tr16_b64_v4i16((LAS v4i16_t*)p)); }
__device__ __forceinline__ bf16x8 cat8(s16x4 a, s16x4 b) { return (bf16x8){a[0], a[1], a[2], a[3], b[0], b[1], b[2], b[3]}; }
__device__ __forceinline__ bf16x8 pack8(float a0, float a1, float a2, float a3, float a4, float a5, float a6, float a7) {
    v4u w; w.x = pk2(a0, a1); w.y = pk2(a2, a3); w.z = pk2(a4, a5); w.w = pk2(a6, a7); return __builtin_bit_cast(bf16x8, w); }
__device__ __forceinline__ float wave_sum(float v) {
#pragma unroll
    for (int o = 1; o < 64; o <<= 1) v += __shfl_xor(v, o);
    return v;
}
namespace pg8 {
#define PG8_LAS __attribute__((address_space(3)))
typedef unsigned short bf16_t;
typedef short bf16x8 __attribute__((ext_vector_type(8)));
typedef float f32x4 __attribute__((ext_vector_type(4)));
typedef unsigned u32x4 __attribute__((ext_vector_type(4)));
typedef unsigned u32x2 __attribute__((ext_vector_type(2)));
constexpr int BM = 256, BK = 64, HALF = 128, HTB = HALF * BK * 2  , STAGE_BYTES = 8 * HTB, NXCD = 8, WGM = 8;

__host__ __device__ __forceinline__ int lds_byte(int r, int c) { const int st = (r >> 4) * 2 + (c >> 5), rr = r & 15, cc = c & 31, ob = rr * 64 + cc * 2; return st * 1024 + (ob ^ (((ob >> 9) & 1) << 5)); }
__host__ __device__ __forceinline__ void stage_rc(int b, int& R, int& C) { const int st = b / 1024, sb = b % 1024, swz = sb ^ (((sb >> 9) & 1) << 5); R = (st >> 1) * 16 + swz / 64; C = (st & 1) * 32 + (swz % 64) / 2; }
__host__ __device__ __forceinline__ int perm32(int rho) { const int n = rho >> 4, i = rho & 15; return 8 * (i >> 2) + 4 * n + (i & 3); }

struct Unit { int pm, pn; };
struct Gemm { const bf16_t* A; const bf16_t* Bt; int M, N, K; };

struct StaticOrder {
    int nM, nN, nwg, G, c, rot;
    __host__ __device__ __forceinline__ void init(int M, int N, int G_, int c_, int rot_ = 0) { nM = M / BM; nN = N / BM; nwg = nM * nN; G = G_; c = c_; rot = rot_; }
    __host__ __device__ __forceinline__ bool next(int i, Unit& u) const {
        const long L = (long)i * G + c; if (L >= nwg) return false;
        int wgid = (int)L; { const int q = nwg / NXCD, r = nwg % NXCD, xcd = wgid % NXCD, off = wgid / NXCD; wgid = (xcd < r ? xcd * (q + 1) : r * (q + 1) + (xcd - r) * q) + off; }
        const int nig = WGM * nN, gid = wgid / nig, fm = gid * WGM, gsz = (nM - fm) < WGM ? (nM - fm) : WGM;
        u.pm = fm + ((wgid % nig) % gsz); const int j = (wgid % nig) / gsz;
        if (rot >= 0) { u.pn = j + rot; if (u.pn >= nN) u.pn -= nN; }
        else u.pn = (j < 8) ? 32 + j : (j < 32) ? j : j - 32;
        return true;
    }
    __device__ __forceinline__ void a_ready(const Unit&) const {}
    __device__ __forceinline__ void done(const Unit&) const {}
};
struct RangeOrder {
    StaticOrder S; int i0, n;
    __host__ __device__ __forceinline__ bool next(int i, Unit& u) const { return i < n && S.next(i0 + i, u); }
    __device__ __forceinline__ void a_ready(const Unit&) const {}
    __device__ __forceinline__ void done(const Unit&) const {}
};

__device__ __forceinline__ unsigned cvt_pk_bf16(float lo, float hi) { unsigned r; asm volatile("v_cvt_pk_bf16_f32 %0, %1, %2" : "=v"(r) : "v"(lo), "v"(hi)); return r; }
typedef float f32x2 __attribute__((ext_vector_type(2)));
template <class Epi, class Sched, bool ALIGN_EPI = false, bool SP2 = false, bool PRE = false, bool LAUNDER = false>
__device__ __forceinline__ void gemm_phase(PG8_LAS unsigned char* lds, const Gemm g, const Sched& S, const Epi& E, f32x4 (*acc0)[2][4][2] = nullptr) {
    int tid_ = threadIdx.x; if constexpr (LAUNDER) asm volatile("" : "+v"(tid_));
    const int tid = tid_, wid = __builtin_amdgcn_readfirstlane(tid >> 6), lane = tid & 63, wr = wid >> 2, wc = wid & 3, fr = lane & 15, fq = lane >> 4;
    const int K = g.K, nt = K / BK;
    unsigned voffA[2], voffB[2];
#pragma unroll
    for (int i = 0; i < 2; ++i) { int R, C; stage_rc(tid * 16 + i * 8192, R, C); const int Rb = Epi::PERM ? ((R & ~31) + perm32(R & 31)) : R;
        voffA[i] = (unsigned)(R * K + C) * 2u; voffB[i] = (unsigned)(Rb * K + C) * 2u; }
    const size_t kstep = (size_t)(BK * 2);
    const size_t hstep = (size_t)HALF * K * 2;
    const size_t tstep = 2 * hstep;
    const unsigned ldsw = (unsigned)wid * 1024u;
    const int aoff = lds_byte(wr * 64 + fr, fq * 8), boff = lds_byte(wc * 32 + fr, fq * 8);
#define PG8_SA(b, h) (((b) * 2 + (h)) * HTB)
#define PG8_SB(b, h) ((4 + (b) * 2 + (h)) * HTB)
#define PG8_STAGE(bufoff, gbase, voff) do { _Pragma("unroll") for (int _i = 0; _i < 2; ++_i) \
        __builtin_amdgcn_global_load_lds((const unsigned*)((const char*)(gbase) + (voff)[_i]), (PG8_LAS unsigned*)(lds + (bufoff) + ldsw + _i * 8192), 16, 0, 0); } while (0)
#define PG8_LDA(dst, b, h) do { _Pragma("unroll") for (int m = 0; m < 4; ++m) _Pragma("unroll") for (int k = 0; k < 2; ++k) dst[m][k] = *(const PG8_LAS bf16x8*)(lds + PG8_SA(b, h) + aoff + m * 2048 + k * 1024); } while (0)
#define PG8_LDB(dst, b, h) do { _Pragma("unroll") for (int n = 0; n < 2; ++n) _Pragma("unroll") for (int k = 0; k < 2; ++k) dst[n][k] = *(const PG8_LAS bf16x8*)(lds + PG8_SB(b, h) + boff + n * 2048 + k * 1024); } while (0)
#define PG8_MMA(ai, bj, At, Bt) do { __builtin_amdgcn_s_setprio(1); _Pragma("unroll") for (int m = 0; m < 4; ++m) _Pragma("unroll") for (int n = 0; n < 2; ++n) _Pragma("unroll") for (int k = 0; k < 2; ++k) \
        acc[ai][bj][m][n] = __builtin_amdgcn_mfma_f32_16x16x32_bf16(Bt[n][k], At[m][k], acc[ai][bj][m][n], 0, 0, 0); __builtin_amdgcn_s_setprio(0); } while (0)
#define PG8_WAIT_V(n) asm volatile("s_waitcnt vmcnt(" #n ")" ::: "memory")
#define PG8_WAIT_L(n) asm volatile("s_waitcnt lgkmcnt(" #n ")" ::: "memory")
#define PG8_BAR __builtin_amdgcn_s_barrier()
#define PG8_SCHED __builtin_amdgcn_sched_barrier(0)
    Unit cur, nxt; int ui = 0;
    if (!S.next(0, cur)) return;
    f32x4 acc[2][2][4][2];
    if constexpr (PRE) {
#pragma unroll
        for (int a = 0; a < 2; ++a)
#pragma unroll
            for (int b = 0; b < 2; ++b)
#pragma unroll
                for (int m = 0; m < 4; ++m)
#pragma unroll
                    for (int n = 0; n < 2; ++n) acc[a][b][m][n] = acc0[a][b][m][n];
    } else if constexpr (Epi::HAS_INIT) E.init(acc, cur, wr, wc, fr, fq);
    else {
#pragma unroll
    for (int a = 0; a < 2; ++a)
#pragma unroll
        for (int b = 0; b < 2; ++b)
#pragma unroll
            for (int m = 0; m < 4; ++m)
#pragma unroll
                for (int n = 0; n < 2; ++n) acc[a][b][m][n] = (f32x4){0.f, 0.f, 0.f, 0.f};
    }
    bf16x8 At[4][2], B0[2][2], B1[2][2];
    const char* cA = (const char*)g.A + (size_t)cur.pm * tstep; const char* cB = (const char*)g.Bt + (size_t)cur.pn * tstep;
    S.a_ready(cur);
    if constexpr (SP2) {
        PG8_STAGE(PG8_SB(0, 0), cB, voffB); PG8_STAGE(PG8_SB(0, 1), cB + hstep, voffB); PG8_STAGE(PG8_SA(0, 0), cA, voffA); PG8_STAGE(PG8_SA(0, 1), cA + hstep, voffA);
        if (wr == 1) PG8_BAR;
        PG8_WAIT_V(2); PG8_BAR;
        PG8_STAGE(PG8_SB(1, 0), cB + kstep, voffB); PG8_STAGE(PG8_SA(1, 0), cA + kstep, voffA); PG8_STAGE(PG8_SB(1, 1), cB + hstep + kstep, voffB);
        PG8_WAIT_V(6); PG8_BAR;
    } else {
        PG8_STAGE(PG8_SB(0, 0), cB, voffB); PG8_STAGE(PG8_SA(0, 0), cA, voffA); PG8_STAGE(PG8_SB(0, 1), cB + hstep, voffB); PG8_STAGE(PG8_SA(0, 1), cA + hstep, voffA);
        if (wr == 1) PG8_BAR;
        PG8_WAIT_V(4); PG8_BAR;
        PG8_STAGE(PG8_SB(1, 0), cB + kstep, voffB); PG8_STAGE(PG8_SA(1, 0), cA + kstep, voffA); PG8_STAGE(PG8_SB(1, 1), cB + hstep + kstep, voffB);
        PG8_WAIT_V(6); PG8_BAR;
    }
    for (;;) {
        const bool has_next = S.next(ui + 1, nxt);
        const char* nA = has_next ? (const char*)g.A + (size_t)nxt.pm * tstep : cA; const char* nB = has_next ? (const char*)g.Bt + (size_t)nxt.pn * tstep : cB;
        for (int t = 0; t < nt; t += 2) {
            if constexpr (Epi::MIDK > 0) { if (t == Epi::MIDK) { int z_ = 0; asm volatile("" : "+v"(z_)); E.mid(acc, cur, wr, wc, fr + z_, fq, -1); } }
            const bool last = (t == nt - 2);
            const char* a1 = cA + (size_t)(t + 1) * kstep;
            const char* a2 = last ? nA : cA + (size_t)(t + 2) * kstep; const char* b2 = last ? nB : cB + (size_t)(t + 2) * kstep;
            const char* a3 = a2 + kstep; const char* b3 = b2 + kstep;
            if (last && has_next) S.a_ready(nxt);
            if constexpr (SP2) {
            PG8_LDB(B0, 0, 0); PG8_LDB(B1, 0, 1); PG8_SCHED; PG8_LDA(At, 0, 0); PG8_STAGE(PG8_SA(1, 1), a1 + hstep, voffA);
            PG8_WAIT_V(8); PG8_WAIT_L(0); PG8_BAR; PG8_MMA(0, 0, At, B0); PG8_MMA(0, 1, At, B1); PG8_BAR; PG8_SCHED;
            PG8_LDA(At, 0, 1); PG8_STAGE(PG8_SB(0, 0), b2, voffB); PG8_STAGE(PG8_SB(0, 1), b2 + hstep, voffB); PG8_STAGE(PG8_SA(0, 0), a2, voffA);
            PG8_WAIT_V(8); PG8_WAIT_L(0); PG8_BAR; PG8_MMA(1, 0, At, B0); PG8_MMA(1, 1, At, B1); PG8_BAR; PG8_SCHED;
            PG8_LDB(B0, 1, 0); PG8_LDB(B1, 1, 1); PG8_SCHED; PG8_LDA(At, 1, 0); PG8_STAGE(PG8_SA(0, 1), a2 + hstep, voffA);
            PG8_WAIT_V(8); PG8_WAIT_L(0); PG8_BAR; PG8_MMA(0, 0, At, B0); PG8_MMA(0, 1, At, B1); PG8_BAR; PG8_SCHED;
            PG8_LDA(At, 1, 1); PG8_STAGE(PG8_SB(1, 0), b3, voffB); PG8_STAGE(PG8_SB(1, 1), b3 + hstep, voffB); PG8_STAGE(PG8_SA(1, 0), a3, voffA);
            PG8_WAIT_V(8); PG8_WAIT_L(0); PG8_BAR; PG8_MMA(1, 0, At, B0); PG8_MMA(1, 1, At, B1); PG8_BAR; PG8_SCHED;
            } else {
            PG8_LDB(B0, 0, 0); PG8_SCHED; PG8_LDA(At, 0, 0); PG8_STAGE(PG8_SA(1, 1), a1 + hstep, voffA);
            PG8_WAIT_L(8); PG8_BAR; PG8_WAIT_L(0); PG8_MMA(0, 0, At, B0); PG8_BAR; PG8_SCHED;
            PG8_LDB(B1, 0, 1); PG8_STAGE(PG8_SB(0, 0), b2, voffB);
            PG8_BAR; PG8_WAIT_L(0); PG8_MMA(0, 1, At, B1); PG8_BAR;
            PG8_LDA(At, 0, 1); PG8_STAGE(PG8_SA(0, 0), a2, voffA);
            PG8_BAR; PG8_WAIT_L(0); PG8_MMA(1, 0, At, B0); PG8_BAR; PG8_SCHED;
            PG8_STAGE(PG8_SB(0, 1), b2 + hstep, voffB);
            PG8_WAIT_V(6); PG8_BAR; PG8_MMA(1, 1, At, B1); PG8_BAR;
            PG8_LDB(B0, 1, 0); PG8_SCHED; PG8_LDA(At, 1, 0); PG8_STAGE(PG8_SA(0, 1), a2 + hstep, voffA);
            PG8_WAIT_L(8); PG8_BAR; PG8_WAIT_L(0); PG8_MMA(0, 0, At, B0); PG8_BAR; PG8_SCHED;
            PG8_LDB(B1, 1, 1); PG8_STAGE(PG8_SB(1, 0), b3, voffB);
            PG8_BAR; PG8_WAIT_L(0); PG8_MMA(0, 1, At, B1); PG8_BAR;
            PG8_LDA(At, 1, 1); PG8_STAGE(PG8_SA(1, 0), a3, voffA);
            PG8_BAR; PG8_WAIT_L(0); PG8_MMA(1, 0, At, B0); PG8_BAR; PG8_SCHED;
            PG8_STAGE(PG8_SB(1, 1), b3 + hstep, voffB);
            PG8_WAIT_V(6); PG8_BAR; PG8_MMA(1, 1, At, B1); PG8_BAR;
            }
        }
        if constexpr (ALIGN_EPI) { if (wr == 0) PG8_BAR; }
        if constexpr (!Epi::AFTER_DRAIN) { E(acc, cur, wr, wc, fr, fq); S.done(cur); }
        if (!has_next) break;
        if constexpr (Epi::HAS_INIT) E.init(acc, nxt, wr, wc, fr, fq);
        else {
#pragma unroll
        for (int a = 0; a < 2; ++a)
#pragma unroll
            for (int b = 0; b < 2; ++b)
#pragma unroll
                for (int m = 0; m < 4; ++m)
#pragma unroll
                    for (int n = 0; n < 2; ++n) acc[a][b][m][n] = (f32x4){0.f, 0.f, 0.f, 0.f};
        }
        cur = nxt; cA = nA; cB = nB; ++ui;
        if constexpr (ALIGN_EPI) { if (wr == 1) PG8_BAR; }
    }
    PG8_WAIT_V(0);
    if constexpr (!ALIGN_EPI) { if (wr == 0) PG8_BAR; }
    PG8_BAR;
    if constexpr (Epi::AFTER_DRAIN) { E.fused(acc, cur, wr, wc, fr, fq, lds, wid, lane); S.done(cur); }
#undef PG8_SA
#undef PG8_SB
#undef PG8_STAGE
#undef PG8_LDA
#undef PG8_LDB
#undef PG8_MMA
#undef PG8_WAIT_V
#undef PG8_WAIT_L
#undef PG8_BAR
#undef PG8_SCHED
}
}
namespace pg8 {
__device__ __forceinline__ float bfu(unsigned short h) { return __uint_as_float((unsigned)h << 16); }
__device__ __forceinline__ void st16_wt(void* p, u32x4 v) { asm volatile("global_store_dwordx4 %0, %1, off sc1\n\ts_nop 1" :: "v"(p), "v"(v) : "memory"); }
__device__ __forceinline__ float sigm(float x) { return __builtin_amdgcn_rcpf(1.0f + __builtin_amdgcn_exp2f(-1.4426950408889634f * x)); }
struct EpiPlain {
    static constexpr bool PERM = true, AFTER_DRAIN = false; static constexpr int MIDK = 0; static constexpr bool HAS_INIT = false;
    bf16_t* O; int ldc; int nrow;
    __device__ __forceinline__ void operator()(const f32x4 (&acc)[2][2][4][2], const Unit& u, int wr, int wc, int fr, int fq) const { run(acc, u, wr, wc, fr, fq, -1); }
    __device__ __forceinline__ void run(const f32x4 (&acc)[2][2][4][2], const Unit& u, int wr, int wc, int fr, int fq, int msel) const {
        const int row0 = u.pm * BM + wr * 64 + fr, col0 = u.pn * BM + wc * 32 + 8 * fq;
#pragma unroll
        for (int ai = 0; ai < 2; ++ai) { if (u.pm * BM + ai * HALF >= nrow) continue;
#pragma unroll
            for (int m = 0; m < 4; ++m) { if (msel >= 0 && m != msel) continue; bf16_t* rowp = O + (size_t)(row0 + ai * HALF + m * 16) * ldc + col0;
#pragma unroll
                for (int bj = 0; bj < 2; ++bj) { const f32x4 v0 = acc[ai][bj][m][0], v1 = acc[ai][bj][m][1];
                    u32x4 w; w.x = cvt_pk_bf16(v0[0], v0[1]); w.y = cvt_pk_bf16(v0[2], v0[3]); w.z = cvt_pk_bf16(v1[0], v1[1]); w.w = cvt_pk_bf16(v1[2], v1[3]);
                    *(u32x4*)(rowp + bj * HALF) = w; } } }
    }
};
template <bool ADD> struct EpiGate {
    static constexpr bool PERM = true, AFTER_DRAIN = false; static constexpr int MIDK = 0; static constexpr bool HAS_INIT = false;
    bf16_t* O; int ldc; const bf16_t* G; int ldg; int nrow;
    __device__ __forceinline__ void operator()(const f32x4 (&acc)[2][2][4][2], const Unit& u, int wr, int wc, int fr, int fq) const { run(acc, u, wr, wc, fr, fq, -1); }
    __device__ __forceinline__ void run(const f32x4 (&acc)[2][2][4][2], const Unit& u, int wr, int wc, int fr, int fq, int msel) const {
        const int row0 = u.pm * BM + wr * 64 + fr, col0 = u.pn * BM + wc * 32 + 8 * fq;
#pragma unroll
        for (int ai = 0; ai < 2; ++ai) { if (u.pm * BM + ai * HALF >= nrow) continue;
#pragma unroll
            for (int m = 0; m < 4; ++m) { if (msel >= 0 && m != msel) continue; const size_t r = (size_t)(row0 + ai * HALF + m * 16); bf16_t* rowp = O + r * ldc + col0; const bf16_t* gp = G + r * ldg + col0;
#pragma unroll
                for (int bj = 0; bj < 2; ++bj) { const f32x4 v0 = acc[ai][bj][m][0], v1 = acc[ai][bj][m][1];
                    const u32x4 gw = *(const u32x4*)(gp + bj * HALF);
                    float o[8];
                    o[0] = v0[0] * sigm(bfu(gw.x & 0xffff)); o[1] = v0[1] * sigm(bfu(gw.x >> 16)); o[2] = v0[2] * sigm(bfu(gw.y & 0xffff)); o[3] = v0[3] * sigm(bfu(gw.y >> 16));
                    o[4] = v1[0] * sigm(bfu(gw.z & 0xffff)); o[5] = v1[1] * sigm(bfu(gw.z >> 16)); o[6] = v1[2] * sigm(bfu(gw.w & 0xffff)); o[7] = v1[3] * sigm(bfu(gw.w >> 16));
                    if (ADD) { const u32x4 pw = *(const u32x4*)(rowp + bj * HALF);
                        o[0] += bfu(pw.x & 0xffff); o[1] += bfu(pw.x >> 16); o[2] += bfu(pw.y & 0xffff); o[3] += bfu(pw.y >> 16);
                        o[4] += bfu(pw.z & 0xffff); o[5] += bfu(pw.z >> 16); o[6] += bfu(pw.w & 0xffff); o[7] += bfu(pw.w >> 16); }
                    u32x4 w; w.x = cvt_pk_bf16(o[0], o[1]); w.y = cvt_pk_bf16(o[2], o[3]); w.z = cvt_pk_bf16(o[4], o[5]); w.w = cvt_pk_bf16(o[6], o[7]);
                    *(u32x4*)(rowp + bj * HALF) = w; } } }
    }
};
struct EpiPlainFull {
    static constexpr bool PERM = true, AFTER_DRAIN = false; static constexpr int MIDK = 0; static constexpr bool HAS_INIT = false;
    bf16_t* O; int ldc;
    __device__ __forceinline__ void operator()(const f32x4 (&acc)[2][2][4][2], const Unit& u, int wr, int wc, int fr, int fq) const {
        const int row0 = u.pm * BM + wr * 64 + fr, col0 = u.pn * BM + wc * 64 + 8 * fq;
#pragma unroll
        for (int ai = 0; ai < 2; ++ai)
#pragma unroll
            for (int m = 0; m < 4; ++m) { bf16_t* rowp = O + (size_t)(row0 + ai * HALF + m * 16) * ldc + col0;
#pragma unroll
                for (int bj = 0; bj < 2; ++bj) { const f32x4 v0 = acc[ai][bj][m][0], v1 = acc[ai][bj][m][1];
                    u32x4 w; w.x = cvt_pk_bf16(v0[0], v0[1]); w.y = cvt_pk_bf16(v0[2], v0[3]); w.z = cvt_pk_bf16(v1[0], v1[1]); w.w = cvt_pk_bf16(v1[2], v1[3]);
                    *(u32x4*)(rowp + bj * 32) = w; } }
    }
};
struct EpiPlainLine {
    static constexpr bool PERM = true, AFTER_DRAIN = false; static constexpr int MIDK = 0; static constexpr bool HAS_INIT = false;
    bf16_t* O; int ldc;
    __device__ __forceinline__ void operator()(const f32x4 (&acc)[2][2][4][2], const Unit& u, int wr, int wc, int fr, int fq) const {
        int z_ = 0; asm volatile("" : "+v"(z_));
        const int row0 = u.pm * BM + wr * 64 + 2 * (fr >> 1) + z_, col0 = u.pn * BM + wc * 64 + 32 * (fr & 1) + 8 * fq;
#pragma unroll
        for (int ai = 0; ai < 2; ++ai)
#pragma unroll
            for (int m = 0; m < 4; ++m)
#pragma unroll
                for (int bj = 0; bj < 2; ++bj) { const f32x4 v0 = acc[ai][bj][m][0], v1 = acc[ai][bj][m][1];
                    u32x4 w; w.x = cvt_pk_bf16(v0[0], v0[1]); w.y = cvt_pk_bf16(v0[2], v0[3]); w.z = cvt_pk_bf16(v1[0], v1[1]); w.w = cvt_pk_bf16(v1[2], v1[3]);
                    *(u32x4*)(O + (size_t)(row0 + ai * HALF + m * 16 + bj) * ldc + col0) = w; }
    }
};
struct EpiNull {
    static constexpr bool PERM = true, AFTER_DRAIN = false; static constexpr int MIDK = 0; static constexpr bool HAS_INIT = false;
    __device__ __forceinline__ void operator()(const f32x4 (&acc)[2][2][4][2], const Unit& u, int wr, int wc, int fr, int fq) const {
#pragma unroll
        for (int ai = 0; ai < 2; ++ai)
#pragma unroll
            for (int bj = 0; bj < 2; ++bj)
#pragma unroll
                for (int m = 0; m < 4; ++m)
#pragma unroll
                    for (int n = 0; n < 2; ++n) asm volatile("" :: "v"(acc[ai][bj][m][n]));
    }
};
struct EpiScratch {
    static constexpr bool PERM = true, AFTER_DRAIN = false; static constexpr int MIDK = 0; static constexpr bool HAS_INIT = false;
    bf16_t* S;
    __device__ __forceinline__ void operator()(const f32x4 (&acc)[2][2][4][2], const Unit& u, int wr, int wc, int fr, int fq) const {
        const int row0 = wr * 64 + fr, col0 = wc * 32 + 8 * fq;
#pragma unroll
        for (int ai = 0; ai < 2; ++ai)
#pragma unroll
            for (int m = 0; m < 4; ++m) { bf16_t* rowp = S + (size_t)(row0 + ai * HALF + m * 16) * 256 + col0;
#pragma unroll
                for (int bj = 0; bj < 2; ++bj) { const f32x4 v0 = acc[ai][bj][m][0], v1 = acc[ai][bj][m][1];
                    u32x4 w; w.x = cvt_pk_bf16(v0[0], v0[1]); w.y = cvt_pk_bf16(v0[2], v0[3]); w.z = cvt_pk_bf16(v1[0], v1[1]); w.w = cvt_pk_bf16(v1[2], v1[3]);
                    *(u32x4*)(rowp + bj * HALF) = w; } }
    }
};
struct EpiMerge {
    static constexpr bool PERM = true, AFTER_DRAIN = false; static constexpr int MIDK_ = 16;
    static constexpr int MIDK = MIDK_; static constexpr bool HAS_INIT = false;
    bf16_t* O; int ldc; const unsigned char* G; size_t ldg; int nrow;
    __device__ __forceinline__ void mid(f32x4 (&acc)[2][2][4][2], const Unit& u, int wr, int wc, int fr, int fq, int msel_) const {
        const int msel = msel_ < 0 ? -1 : (msel_ & 15), bsel = msel_ < 0 ? -1 : ((msel_ >> 4) - 1);
        const int row0 = u.pm * BM + wr * 64 + fr, col0 = u.pn * BM + wc * 32 + 8 * fq;
        if (msel_ < 0) {
            const int wcol = u.pn * BM + wc * 32 + HALF * (fq & 1) + 16 * (fq >> 1);
#pragma unroll
            for (int ai = 0; ai < 2; ++ai) { if (u.pm * BM + ai * HALF >= nrow) continue;
                u32x4 gaw[4], gbw[4];
#pragma unroll
                for (int m = 0; m < 4; ++m) { const size_t r = (size_t)(row0 + ai * HALF + m * 16); gaw[m] = *(const u32x4*)(G + r * ldg + wcol); gbw[m] = *(const u32x4*)(G + r * ldg + 1024 + wcol); }
#pragma unroll
                for (int m = 0; m < 4; ++m) {
                    unsigned aw[2][2] = {{gaw[m].x, gaw[m].y}, {gaw[m].z, gaw[m].w}}, bw[2][2] = {{gbw[m].x, gbw[m].y}, {gbw[m].z, gbw[m].w}};
#pragma unroll
                    for (int n = 0; n < 2; ++n) { { auto r_ = __builtin_amdgcn_permlane16_swap(aw[0][n], aw[1][n], false, false); aw[0][n] = r_[0]; aw[1][n] = r_[1]; }
                                                  { auto r_ = __builtin_amdgcn_permlane16_swap(bw[0][n], bw[1][n], false, false); bw[0][n] = r_[0]; bw[1][n] = r_[1]; } }
#pragma unroll
                    for (int bj = 0; bj < 2; ++bj)
#pragma unroll
                        for (int n = 0; n < 2; ++n)
#pragma unroll
                            for (int q = 0; q < 4; ++q) acc[ai][bj][m][n][q] *= (float)((aw[bj][n] >> (8 * q)) & 0xffu) * __builtin_amdgcn_rcpf((float)((bw[bj][n] >> (8 * q)) & 0xffu)); } }
            return;
        }
#pragma unroll
        for (int ai = 0; ai < 2; ++ai) { if (u.pm * BM + ai * HALF >= nrow) continue;
            u32x2 ga_[4][2], gb_[4][2];
#pragma unroll
            for (int m = 0; m < 4; ++m) { if (msel >= 0 && m != msel) continue; const size_t r = (size_t)(row0 + ai * HALF + m * 16);
#pragma unroll
                for (int bj = 0; bj < 2; ++bj) { if (bsel >= 0 && bj != bsel) continue; ga_[m][bj] = *(const u32x2*)(G + r * ldg + col0 + bj * HALF); gb_[m][bj] = *(const u32x2*)(G + r * ldg + 1024 + col0 + bj * HALF); } }
#pragma unroll
            for (int m = 0; m < 4; ++m) { if (msel >= 0 && m != msel) continue;
#pragma unroll
                for (int bj = 0; bj < 2; ++bj) { if (bsel >= 0 && bj != bsel) continue; const unsigned aw[2] = {ga_[m][bj].x, ga_[m][bj].y}, bw[2] = {gb_[m][bj].x, gb_[m][bj].y};
#pragma unroll
                    for (int n = 0; n < 2; ++n)
#pragma unroll
                        for (int q = 0; q < 4; ++q) acc[ai][bj][m][n][q] *= (float)((aw[n] >> (8 * q)) & 0xffu) * __builtin_amdgcn_rcpf((float)((bw[n] >> (8 * q)) & 0xffu)); } } }
    }
    __device__ __forceinline__ void operator()(const f32x4 (&acc)[2][2][4][2], const Unit& u, int wr, int wc, int fr, int fq) const { run(acc, u, wr, wc, fr, fq, -1); }
    __device__ __forceinline__ void run(const f32x4 (&acc)[2][2][4][2], const Unit& u, int wr, int wc, int fr, int fq, int msel_) const {
        const int msel = msel_ < 0 ? -1 : (msel_ & 15), bsel = msel_ < 0 ? -1 : ((msel_ >> 4) - 1);
        const int row0 = u.pm * BM + wr * 64 + fr, col0 = u.pn * BM + wc * 32 + 8 * fq;
        if (msel_ < 0) {
            const int wcol = u.pn * BM + wc * 32 + HALF * (fq & 1) + 16 * (fq >> 1);
#pragma unroll
            for (int ai = 0; ai < 2; ++ai) { if (u.pm * BM + ai * HALF >= nrow) continue;
                u32x4 gbw[4];
#pragma unroll
                for (int m = 0; m < 4; ++m) { const size_t r = (size_t)(row0 + ai * HALF + m * 16); gbw[m] = *(const u32x4*)(G + r * ldg + 1024 + wcol); }
#pragma unroll
                for (int m = 0; m < 4; ++m) { const size_t r = (size_t)(row0 + ai * HALF + m * 16); bf16_t* rowp = O + r * ldc + col0;
                    unsigned bw[2][2] = {{gbw[m].x, gbw[m].y}, {gbw[m].z, gbw[m].w}};
#pragma unroll
                    for (int n = 0; n < 2; ++n) { auto r_ = __builtin_amdgcn_permlane16_swap(bw[0][n], bw[1][n], false, false); bw[0][n] = r_[0]; bw[1][n] = r_[1]; }
#pragma unroll
                    for (int bj = 0; bj < 2; ++bj) { float o[8];
#pragma unroll
                        for (int n = 0; n < 2; ++n)
#pragma unroll
                            for (int q = 0; q < 4; ++q) o[4 * n + q] = acc[ai][bj][m][n][q] * ((float)((bw[bj][n] >> (8 * q)) & 0xffu) * (1.0f / 255.0f));
                        u32x4 w; w.x = cvt_pk_bf16(o[0], o[1]); w.y = cvt_pk_bf16(o[2], o[3]); w.z = cvt_pk_bf16(o[4], o[5]); w.w = cvt_pk_bf16(o[6], o[7]);
                        *(u32x4*)(rowp + bj * HALF) = w; } } }
            return;
        }
#pragma unroll
        for (int ai = 0; ai < 2; ++ai) { if (u.pm * BM + ai * HALF >= nrow) continue;
            u32x2 gb_[4][2];
#pragma unroll
            for (int m = 0; m < 4; ++m) { if (msel >= 0 && m != msel) continue; const size_t r = (size_t)(row0 + ai * HALF + m * 16);
#pragma unroll
                for (int bj = 0; bj < 2; ++bj) { if (bsel >= 0 && bj != bsel) continue; gb_[m][bj] = *(const u32x2*)(G + r * ldg + 1024 + col0 + bj * HALF); } }
#pragma unroll
            for (int m = 0; m < 4; ++m) { if (msel >= 0 && m != msel) continue; const size_t r = (size_t)(row0 + ai * HALF + m * 16); bf16_t* rowp = O + r * ldc + col0;
#pragma unroll
                for (int bj = 0; bj < 2; ++bj) { if (bsel >= 0 && bj != bsel) continue; const unsigned bw[2] = {gb_[m][bj].x, gb_[m][bj].y}; float o[8];
#pragma unroll
                    for (int n = 0; n < 2; ++n)
#pragma unroll
                        for (int q = 0; q < 4; ++q) o[4 * n + q] = acc[ai][bj][m][n][q] * ((float)((bw[n] >> (8 * q)) & 0xffu) * (1.0f / 255.0f));
                    u32x4 w; w.x = cvt_pk_bf16(o[0], o[1]); w.y = cvt_pk_bf16(o[2], o[3]); w.z = cvt_pk_bf16(o[4], o[5]); w.w = cvt_pk_bf16(o[6], o[7]);
                    *(u32x4*)(rowp + bj * HALF) = w; } } }
    }
};
struct EpiResidual {
    static constexpr bool PERM = false, AFTER_DRAIN = false; static constexpr int MIDK = 0; static constexpr bool HAS_INIT = true;
    const float* xa; const float* xb; float* out; int ldc, nrow_a, nrow;
    __device__ __forceinline__ void init(f32x4 (&acc)[2][2][4][2], const Unit& u, int wr, int wc, int fr, int fq) const {
        const int row0 = u.pm * BM + wr * 64 + fr, col0 = u.pn * BM + wc * 32 + 4 * fq;
#pragma unroll
        for (int ai = 0; ai < 2; ++ai)
#pragma unroll
            for (int m = 0; m < 4; ++m) { const int r = row0 + ai * HALF + m * 16; const float* xp = xa + (size_t)r * ldc;
#pragma unroll
                for (int bj = 0; bj < 2; ++bj)
#pragma unroll
                    for (int n = 0; n < 2; ++n) acc[ai][bj][m][n] = __builtin_nontemporal_load((const f32x4*)(xp + col0 + bj * HALF + n * 16)); }
    }
    __device__ __forceinline__ void operator()(const f32x4 (&acc)[2][2][4][2], const Unit& u, int wr, int wc, int fr, int fq) const { run(acc, u, wr, wc, fr, fq, -1); }
    __device__ __forceinline__ void run(const f32x4 (&acc)[2][2][4][2], const Unit& u, int wr, int wc, int fr, int fq, int msel_) const {
        const int msel = msel_ < 0 ? -1 : (msel_ & 15), bsel = msel_ < 0 ? -1 : ((msel_ >> 4) - 1);
        const int row0 = u.pm * BM + wr * 64 + fr, col0 = u.pn * BM + wc * 32 + 4 * fq;
#pragma unroll
        for (int ai = 0; ai < 2; ++ai)
#pragma unroll
            for (int m = 0; m < 4; ++m) { if (msel >= 0 && m != msel) continue; const int r = row0 + ai * HALF + m * 16;
                if (r < nrow) { const float* xp = (r < nrow_a) ? xa + (size_t)r * ldc : xb + (size_t)(r - nrow_a) * ldc; float* op = out + (size_t)r * ldc;
#pragma unroll
                    for (int bj = 0; bj < 2; ++bj) { if (bsel >= 0 && bj != bsel) continue;
#pragma unroll
                        for (int n = 0; n < 2; ++n) { const int c = col0 + bj * HALF + n * 16; f32x4 v = acc[ai][bj][m][n]; if (msel >= 0) v += *(const f32x4*)(xp + c); __builtin_nontemporal_store(v, (f32x4*)(op + c)); } } } }
    }
};
struct EpiInProj {
    static constexpr bool PERM = true, AFTER_DRAIN = false; static constexpr int MIDK = 0; static constexpr bool HAS_INIT = false;
    bf16_t* P; float* out; const f32x4* rope;
    __device__ __forceinline__ void operator()(const f32x4 (&acc)[2][2][4][2], const Unit& u, int wr, int wc, int fr, int fq) const { run(acc, u, wr, wc, fr, fq, -1); }
    __device__ __forceinline__ void run(const f32x4 (&acc)[2][2][4][2], const Unit& u, int wr, int wc, int fr, int fq, int msel) const {
        const int pn = u.pn, rowbase = u.pm * BM + wr * 64 + fr;
        if (pn < 4) {
            const bool isk = pn >= 2; const float sc = isk ? 0.08838834764831845f : 1.0f;
            const int jb = (32 * wc + 8 * fq) & 63, hd = (pn & 1) * 2 + (wc >> 1);
            const int colbase = (isk ? C_RK : C_RQ) + hd * 128 + jb;
#pragma unroll
            for (int ai = 0; ai < 2; ++ai) { if (u.pm * BM + ai * HALF >= MR) continue;
#pragma unroll
              for (int mp = 0; mp < 2 - ai; ++mp) { const int mlo = 2 * mp, mhi = (ai == 0) ? 2 * mp + 2 : 4;
                f32x4 t1[4], t2[4][4];
                { const int r0 = rowbase + ai * HALF; const int pos0 = (r0 < MP) ? (r0 & (TP - 1)) : 16384; const f32x4* c1 = rope + (size_t)(pos0 >> 7) * 32 + (jb >> 1);
#pragma unroll
                  for (int q = 0; q < 4; ++q) t1[q] = c1[q]; }
#pragma unroll
                for (int m = 0; m < 4; ++m) { if (m < mlo || m >= mhi) continue; if (msel >= 0 && m != msel) continue; const int r = rowbase + ai * HALF + m * 16;
                    const int pos = (r < MP) ? (r & (TP - 1)) : (16384 + ((r - MP) & 3));
                    const f32x4* c2 = rope + (size_t)(129 + (pos & 127)) * 32 + (jb >> 1);
#pragma unroll
                    for (int q = 0; q < 4; ++q) t2[m][q] = c2[q]; }
#pragma unroll
                for (int m = 0; m < 4; ++m) { if (m < mlo || m >= mhi) continue; if (msel >= 0 && m != msel) continue; const int r = rowbase + ai * HALF + m * 16;
                    float o1[8], o2[8];
#pragma unroll
                    for (int n = 0; n < 2; ++n) { const f32x4 a = acc[ai][0][m][n] * sc, b = acc[ai][1][m][n] * sc;
#pragma unroll
                        for (int hp = 0; hp < 2; ++hp) { const f32x4 u1 = t1[2 * n + hp], u2 = t2[m][2 * n + hp];
                            const float ca = u1[0] * u2[0] - u1[1] * u2[1], sa = u1[1] * u2[0] + u1[0] * u2[1], cb = u1[2] * u2[2] - u1[3] * u2[3], sb = u1[3] * u2[2] + u1[2] * u2[3];
                            o1[4 * n + 2 * hp] = a[2 * hp] * ca - b[2 * hp] * sa; o2[4 * n + 2 * hp] = a[2 * hp] * sa + b[2 * hp] * ca;
                            o1[4 * n + 2 * hp + 1] = a[2 * hp + 1] * cb - b[2 * hp + 1] * sb; o2[4 * n + 2 * hp + 1] = a[2 * hp + 1] * sb + b[2 * hp + 1] * cb; } }
                    bf16_t* dp = P + (size_t)r * INW + colbase;
                    u32x4 w1, w2; w1.x = cvt_pk_bf16(o1[0], o1[1]); w1.y = cvt_pk_bf16(o1[2], o1[3]); w1.z = cvt_pk_bf16(o1[4], o1[5]); w1.w = cvt_pk_bf16(o1[6], o1[7]);
                    w2.x = cvt_pk_bf16(o2[0], o2[1]); w2.y = cvt_pk_bf16(o2[2], o2[3]); w2.z = cvt_pk_bf16(o2[4], o2[5]); w2.w = cvt_pk_bf16(o2[6], o2[7]);
                    *(u32x4*)dp = w1; *(u32x4*)(dp + 64) = w2; } } }
        } else if (pn >= 12 && pn < 24) {
            const bool isk = pn >= 18; const int hd = (isk ? pn - 18 : pn - 12) * 4 + wc, g = hd >> 3, h = hd & 7;
            int zg_ = 0; asm volatile("" : "+v"(zg_));
            const PG8_LAS float* gp = (const PG8_LAS float*)(size_t)(GAINS_OFF + zg_) + (isk ? 64 : 0) + 8 * fq;
            f32x4 gn[2][2];
#pragma unroll
            for (int bj = 0; bj < 2; ++bj)
#pragma unroll
                for (int n = 0; n < 2; ++n) gn[bj][n] = *(const PG8_LAS f32x4*)(gp + bj * 32 + 4 * n);
            const int win = (g == 0) ? 128 : (g == 1 ? 512 : 2048);
            const size_t okp = (g == 0) ? O_KVP0 : (g == 1 ? O_KVP1 : O_KVP2), oks = (g == 0) ? O_KVS0 : (g == 1 ? O_KVS1 : O_KVS2);
#pragma unroll
            for (int ai = 0; ai < 2; ++ai) { if (u.pm * BM + ai * HALF >= MR) continue;
#pragma unroll
                for (int m = 0; m < 4; ++m) { if (msel >= 0 && m != msel) continue; const int r = rowbase + ai * HALF + m * 16;
                    float ss = 0.f;
#pragma unroll
                    for (int bj = 0; bj < 2; ++bj)
#pragma unroll
                        for (int n = 0; n < 2; ++n) { const f32x4 x = acc[ai][bj][m][n]; ss += (x[0] * x[0] + x[1] * x[1]) + (x[2] * x[2] + x[3] * x[3]); }
                    ss += __shfl_xor(ss, 16); ss += __shfl_xor(ss, 32);
                    const float rs = __builtin_amdgcn_rsqf(ss * (1.0f / 64.0f) + EPSF);
                    bf16_t* dp = P + (size_t)r * INW + (isk ? C_AK : C_AQ) + hd * 64 + 8 * fq;
                    float* kvp = nullptr;
                    if (isk) { if (r < MP) { const int b = r >> 13, t = r & (TP - 1); if (t >= TP - win) kvp = out + okp + ((size_t)(b * win + (t - (TP - win))) * 2) * 512 + h * 64 + 8 * fq; }
                               else { kvp = out + oks + ((size_t)(r - MP) * 2) * 512 + h * 64 + 8 * fq; } }
#pragma unroll
                    for (int bj = 0; bj < 2; ++bj) { const f32x4 y0 = acc[ai][bj][m][0] * rs * gn[bj][0], y1 = acc[ai][bj][m][1] * rs * gn[bj][1];
                        u32x4 w; w.x = cvt_pk_bf16(y0[0], y0[1]); w.y = cvt_pk_bf16(y0[2], y0[3]); w.z = cvt_pk_bf16(y1[0], y1[1]); w.w = cvt_pk_bf16(y1[2], y1[3]);
                        *(u32x4*)(dp + bj * 32) = w;
                        if (kvp) { *(f32x4*)(kvp + bj * 32) = y0; *(f32x4*)(kvp + bj * 32 + 4) = y1; } } } }
        } else if (pn >= 32) {
            const int gc0 = (pn - 32) * BM + wc * 64 + 8 * fq;
#pragma unroll
            for (int ai = 0; ai < 2; ++ai) { if (u.pm * BM + ai * HALF >= MR) continue;
#pragma unroll
                for (int m = 0; m < 4; ++m) { if (msel >= 0 && m != msel) continue; const int r = rowbase + ai * HALF + m * 16; unsigned char* rowp = (unsigned char*)(P + (size_t)r * INW) + GATE_OFF + gc0;
                    unsigned w[2][2];
#pragma unroll
                    for (int bj = 0; bj < 2; ++bj)
#pragma unroll
                        for (int n = 0; n < 2; ++n) { const f32x4 v = acc[ai][bj][m][n]; unsigned pk = 0u;
#pragma unroll
                            for (int e = 0; e < 4; ++e) { const float d = __builtin_fmaf(__builtin_amdgcn_exp2f(v[e]), 1.0f / 255.0f, 1.0f / 255.0f);
                                pk = __builtin_amdgcn_cvt_pk_u8_f32(fmaxf(__builtin_amdgcn_rcpf(d), 1.0f), e, pk); }
                            w[bj][n] = pk; }
#pragma unroll
                    for (int n = 0; n < 2; ++n) { auto r_ = __builtin_amdgcn_permlane16_swap(w[0][n], w[1][n], false, false); w[0][n] = r_[0]; w[1][n] = r_[1]; }
                    u32x4 ww; ww.x = w[0][0]; ww.y = w[0][1]; ww.z = w[1][0]; ww.w = w[1][1];
                    *(u32x4*)(rowp - 8 * fq + 32 * (fq & 1) + 16 * (fq >> 1)) = ww; } }
        } else {
            const bool isv = (pn >= 24 && pn < 30), issilu = (pn >= 8 && pn < 12) || pn == 30 || pn == 31;
            const int col0 = pn * BM + wc * 64 + 8 * fq;
#pragma unroll
            for (int ai = 0; ai < 2; ++ai) { if (u.pm * BM + ai * HALF >= MR) continue;
#pragma unroll
                for (int m = 0; m < 4; ++m) { if (msel >= 0 && m != msel) continue; const int r = rowbase + ai * HALF + m * 16; bf16_t* rowp = P + (size_t)r * INW + col0;
#pragma unroll
                    for (int bj = 0; bj < 2; ++bj) { f32x4 v0 = acc[ai][bj][m][0], v1 = acc[ai][bj][m][1];
                        if (issilu) {
#pragma unroll
                            for (int q = 0; q < 4; ++q) { v0[q] *= sigm(v0[q]); v1[q] *= sigm(v1[q]); } }
                        u32x4 w; w.x = cvt_pk_bf16(v0[0], v0[1]); w.y = cvt_pk_bf16(v0[2], v0[3]); w.z = cvt_pk_bf16(v1[0], v1[1]); w.w = cvt_pk_bf16(v1[2], v1[3]);
                        *(u32x4*)(rowp + bj * 32) = w;
                        if (isv) { const int hd = (pn - 24) * 4 + wc, g = hd >> 3, h = hd & 7, d0 = 32 * bj + 8 * fq;
                            const int win = (g == 0) ? 128 : (g == 1 ? 512 : 2048);
                            float* kvp = nullptr;
                            if (r < MP) { const int b = r >> 13, t = r & (TP - 1); if (t >= TP - win) kvp = out + ((g == 0) ? O_KVP0 : (g == 1 ? O_KVP1 : O_KVP2)) + ((size_t)(b * win + (t - (TP - win))) * 2 + 1) * 512 + h * 64 + d0; }
                            else kvp = out + ((g == 0) ? O_KVS0 : (g == 1 ? O_KVS1 : O_KVS2)) + ((size_t)(r - MP) * 2 + 1) * 512 + h * 64 + d0;
                            if (kvp) { *(f32x4*)kvp = v0; *(f32x4*)(kvp + 4) = v1; } } } } }
        }
    }
};
__host__ __device__ __forceinline__ int inproj_rowmap(int col) {
    if (col < 1024) { const int tile = col >> 8, hdl = (col >> 7) & 1, half = (col >> 6) & 1, j = col & 63; return tile * 256 + half * 128 + hdl * 64 + j; }
    if (col >= C_AQ && col < C_AV) { const int off = col & 255, base = col - off, head = off >> 6, d = off & 63; return base + (d >> 5) * 128 + head * 32 + (d & 31); }
    { const int off = col & 255, base = col - off, wc = off >> 6, bj = (off >> 5) & 1, x = off & 31; return base + bj * 128 + wc * 32 + x; }
}
template <int K, bool PERM>
__device__ __forceinline__ void g128_accum(PG8_LAS unsigned char* lds, const bf16_t* A, int lda, const bf16_t* Bt, int ldb, int pn, int wc, f32x4 (&c)[2][2]) {
    const int tid = threadIdx.x, wid = __builtin_amdgcn_readfirstlane(tid >> 6), lane = tid & 63, wr = wid >> 2, ms = wid & 3, fr = lane & 15, fq = lane >> 4;
    constexpr int RS = K * 2 + 16, CPR = K / 8, NIT = 64 * CPR / 512;
    u32x4 st[NIT];
#pragma unroll
    for (int it = 0; it < NIT; ++it) { const int id = tid + 512 * it, lrow = id / CPR, ch = id % CPR, bj = lrow >> 5, n = (lrow >> 4) & 1, i = lrow & 15;
        const int brow = pn * BM + bj * HALF + wc * 32 + (PERM ? (8 * (i >> 2) + 4 * n + (i & 3)) : (16 * n + i));
        st[it] = *(const u32x4*)(Bt + (size_t)brow * ldb + ch * 8); }
    const bf16_t* ap = A + (size_t)(wr * 64 + ms * 16 + fr) * lda + 8 * fq;
    constexpr int NS = K / 32;
    bf16x8 af[NS];
#pragma unroll
    for (int s = 0; s < NS; ++s) af[s] = *(const bf16x8*)(ap + 32 * s);
#pragma unroll
    for (int it = 0; it < NIT; ++it) { const int id = tid + 512 * it, lrow = id / CPR, ch = id % CPR; *(PG8_LAS u32x4*)(lds + lrow * RS + ch * 16) = st[it]; }
    __syncthreads();
    const PG8_LAS unsigned char* bl = lds + fr * RS + 16 * fq;
#pragma unroll
    for (int s = 0; s < NS; ++s) {
#pragma unroll
        for (int bj = 0; bj < 2; ++bj)
#pragma unroll
            for (int n = 0; n < 2; ++n) { const bf16x8 bf = *(const PG8_LAS bf16x8*)(bl + (bj * 32 + n * 16) * RS + (32 * s) * 2); c[bj][n] = __builtin_amdgcn_mfma_f32_16x16x32_bf16(bf, af[s], c[bj][n], 0, 0, 0); }
    }
    __syncthreads();
}
#define G128_FILL(acc, c) do { _Pragma("unroll") for (int a_ = 0; a_ < 2; ++a_) _Pragma("unroll") for (int b_ = 0; b_ < 2; ++b_) _Pragma("unroll") for (int m_ = 0; m_ < 4; ++m_) _Pragma("unroll") for (int n_ = 0; n_ < 2; ++n_) \
        acc[a_][b_][m_][n_] = (a_ == 0) ? c[b_][n_] : (f32x4){0.f, 0.f, 0.f, 0.f}; } while (0)
template <int K, class Epi>
__device__ __forceinline__ void gemm128_direct(PG8_LAS unsigned char* lds, const bf16_t* A, const bf16_t* Bt, int pm, int unit, const Epi& E) {
    const int tid = threadIdx.x, wid = __builtin_amdgcn_readfirstlane(tid >> 6), lane = tid & 63, wr = wid >> 2, ms = wid & 3, fr = lane & 15, fq = lane >> 4;
    const int pn = unit >> 2, wc = unit & 3;
    f32x4 c[2][2];
#pragma unroll
    for (int b = 0; b < 2; ++b)
#pragma unroll
        for (int n = 0; n < 2; ++n) c[b][n] = (f32x4){0.f, 0.f, 0.f, 0.f};
    g128_accum<K, Epi::PERM>(lds, A, K, Bt, K, pn, wc, c);
    f32x4 acc[2][2][4][2]; G128_FILL(acc, c);
    E.run(acc, Unit{pm, pn}, wr, wc, fr, fq, ms);
}
__device__ __forceinline__ void gemm128_merge(PG8_LAS unsigned char* lds, const bf16_t* A, const bf16_t* Bt, int pm, int unit, const EpiMerge& E) {
    const int tid = threadIdx.x, wid = __builtin_amdgcn_readfirstlane(tid >> 6), lane = tid & 63, wr = wid >> 2, ms = wid & 3, fr = lane & 15, fq = lane >> 4;
    const int pn = unit >> 2, wc = unit & 3;
    f32x4 c[2][2];
#pragma unroll
    for (int b = 0; b < 2; ++b)
#pragma unroll
        for (int n = 0; n < 2; ++n) c[b][n] = (f32x4){0.f, 0.f, 0.f, 0.f};
    g128_accum<1024, true>(lds, A, 1536, Bt, 1536, pn, wc, c);
    { f32x4 acc[2][2][4][2]; G128_FILL(acc, c); E.mid(acc, Unit{pm, pn}, wr, wc, fr, fq, ms);
#pragma unroll
      for (int b = 0; b < 2; ++b)
#pragma unroll
          for (int n = 0; n < 2; ++n) { c[b][n] = (ms == 0) ? acc[0][b][0][n] : (ms == 1) ? acc[0][b][1][n] : (ms == 2) ? acc[0][b][2][n] : acc[0][b][3][n]; } }
    g128_accum<512, true>(lds, A + 1024, 1536, Bt + 1024, 1536, pn, wc, c);
    f32x4 acc[2][2][4][2]; G128_FILL(acc, c);
    E.run(acc, Unit{pm, pn}, wr, wc, fr, fq, ms);
}
template <int K, int KH, class Epi>
__device__ __forceinline__ void gemm128_half(PG8_LAS unsigned char* lds, const bf16_t* A, int lda, const bf16_t* Bt, int ldb, int pm, int unit, const Epi& E) {
    const int tid = threadIdx.x, wid = __builtin_amdgcn_readfirstlane(tid >> 6), lane = tid & 63, wr = wid >> 2, ms = wid & 3, fr = lane & 15, fq = lane >> 4;
    const int pn = unit >> 3, wc = (unit >> 1) & 3, bj = unit & 1;
    constexpr int RS = K * 2 + 16, CPR = K / 8, NIT = 32 * CPR / 512, NS = K / 32;
    u32x4 st[NIT];
#pragma unroll
    for (int it = 0; it < NIT; ++it) { const int id = tid + 512 * it, lrow = id / CPR, ch = id % CPR, n = lrow >> 4, i = lrow & 15;
        const int brow = pn * BM + bj * HALF + wc * 32 + (Epi::PERM ? (8 * (i >> 2) + 4 * n + (i & 3)) : (16 * n + i));
        st[it] = *(const u32x4*)(Bt + (size_t)brow * ldb + ch * 8); }
    const bf16_t* ap = A + (size_t)(wr * 64 + ms * 16 + fr) * lda + 8 * fq;
    bf16x8 af[16];
#pragma unroll
    for (int s = 0; s < 16; ++s) af[s] = *(const bf16x8*)(ap + 32 * s);
#pragma unroll
    for (int it = 0; it < NIT; ++it) { const int id = tid + 512 * it, lrow = id / CPR, ch = id % CPR; *(PG8_LAS u32x4*)(lds + lrow * RS + ch * 16) = st[it]; }
    __syncthreads();
    f32x4 c[2] = {(f32x4){0.f, 0.f, 0.f, 0.f}, (f32x4){0.f, 0.f, 0.f, 0.f}};
    const PG8_LAS unsigned char* bl = lds + fr * RS + 16 * fq;
    const int mcode = ms | ((1 + bj) << 4);
#pragma unroll
    for (int h2 = 0; h2 < NS / 16; ++h2) {
        bf16x8 an[16];
        if (h2 + 1 < NS / 16) {
#pragma unroll
            for (int s = 0; s < 16; ++s) an[s] = *(const bf16x8*)(ap + 512 * (h2 + 1) + 32 * s);
        }
#pragma unroll
        for (int s = 0; s < 16; ++s) {
            if (KH > 0 && 16 * h2 + s == KH / 32) { f32x4 acc[2][2][4][2];
#pragma unroll
                for (int a_ = 0; a_ < 2; ++a_)
#pragma unroll
                    for (int b_ = 0; b_ < 2; ++b_)
#pragma unroll
                        for (int m_ = 0; m_ < 4; ++m_)
#pragma unroll
                            for (int n_ = 0; n_ < 2; ++n_) acc[a_][b_][m_][n_] = (a_ == 0) ? c[n_] : (f32x4){0.f, 0.f, 0.f, 0.f};
                if constexpr (KH > 0) E.mid(acc, Unit{pm, pn}, wr, wc, fr, fq, mcode);
#pragma unroll
                for (int n_ = 0; n_ < 2; ++n_) c[n_] = (bj == 0) ? ((ms == 0) ? acc[0][0][0][n_] : (ms == 1) ? acc[0][0][1][n_] : (ms == 2) ? acc[0][0][2][n_] : acc[0][0][3][n_])
                                                                 : ((ms == 0) ? acc[0][1][0][n_] : (ms == 1) ? acc[0][1][1][n_] : (ms == 2) ? acc[0][1][2][n_] : acc[0][1][3][n_]); }
#pragma unroll
            for (int n = 0; n < 2; ++n) { const bf16x8 bf = *(const PG8_LAS bf16x8*)(bl + (n * 16) * RS + (512 * h2 + 32 * s) * 2); c[n] = __builtin_amdgcn_mfma_f32_16x16x32_bf16(bf, af[s], c[n], 0, 0, 0); }
        }
        if (h2 + 1 < NS / 16) {
#pragma unroll
            for (int s = 0; s < 16; ++s) af[s] = an[s];
        }
    }
    f32x4 acc[2][2][4][2];
#pragma unroll
    for (int a_ = 0; a_ < 2; ++a_)
#pragma unroll
        for (int b_ = 0; b_ < 2; ++b_)
#pragma unroll
            for (int m_ = 0; m_ < 4; ++m_)
#pragma unroll
                for (int n_ = 0; n_ < 2; ++n_) acc[a_][b_][m_][n_] = (a_ == 0) ? c[n_] : (f32x4){0.f, 0.f, 0.f, 0.f};
    E.run(acc, Unit{pm, pn}, wr, wc, fr, fq, mcode);
    __syncthreads();
}
}
#define XB_TMO      128
#define XB_XCNT(j)  (256  + 64 * (j))
#define XB_XSUB(j)  (1280 + 64 * (j))
#define XB_XGEN(j)  (2304 + 64 * (j))
#define XB_TOP      3328
#define XB_TOPGEN   3392
#define XB_SSUB(i, j) (3520 + 1088 * (i) + 64 * (j))
#define XB_STOP(i)    (3520 + 1088 * (i) + 1024)
#define XCD_BAR_WORDS 12224
#define XB_SPIN_CAP (1u << 18)

__device__ __forceinline__ unsigned xb_ld(unsigned* p)              { return __hip_atomic_load(p, __ATOMIC_RELAXED, __HIP_MEMORY_SCOPE_AGENT); }
__device__ __forceinline__ unsigned xb_add(unsigned* p, unsigned v) { return __hip_atomic_fetch_add(p, v, __ATOMIC_RELAXED, __HIP_MEMORY_SCOPE_AGENT); }
__device__ __forceinline__ unsigned xb_xcc_id() { return (unsigned)__builtin_amdgcn_s_getreg((3 << 11) | 20) & 0xFu; }
#define XB_SPIN(cond, bar) do { unsigned _sp = 0; while (cond) { __builtin_amdgcn_s_sleep(1); \
    if ((++_sp & 255u) == 0u) { if (xb_ld(&(bar)[XB_TMO])) break; if (_sp > XB_SPIN_CAP) { atomicAdd(&(bar)[XB_TMO], 1u); break; } } } } while (0)

struct XcdBarrier {
    unsigned* bar; unsigned x;
    volatile LAS unsigned* st;
};

__device__ __forceinline__ XcdBarrier xcd_barrier_post(unsigned* bar, volatile LAS unsigned* st) {
    XcdBarrier b; b.bar = bar; b.x = xb_xcc_id(); b.st = st;
    if (threadIdx.x == 0) (void)xb_add(&bar[XB_XCNT(b.x)], 1u);
    return b;
}
__device__ __forceinline__ void xcd_barrier_complete(unsigned* bar, unsigned x, unsigned& nloc, unsigned& nx) {
    const unsigned G = gridDim.x * gridDim.y * gridDim.z;
    unsigned sum, cnt, mine, sp = 0u;
    for (;;) {
        sum = 0u; cnt = 0u; mine = 0u;
#pragma unroll
        for (unsigned j = 0; j < 16; ++j) { const unsigned c = xb_ld(&bar[XB_XCNT(j)]); sum += c; cnt += (c > 0u) ? 1u : 0u; mine = (j == x) ? c : mine; }
        if (sum == G) break;
        __builtin_amdgcn_s_sleep(1);
        if ((++sp & 255u) == 0u) { if (xb_ld(&bar[XB_TMO])) break; if (sp > XB_SPIN_CAP) { atomicAdd(&bar[XB_TMO], 1u); break; } }
    }
    nloc = mine > 0u ? mine : 1u; nx = cnt > 0u ? cnt : 1u;
}

__device__ __forceinline__ void xcd_barrier(const XcdBarrier& b) {
    asm volatile("s_waitcnt vmcnt(0)" ::: "memory");
    __syncthreads();
    if (threadIdx.x == 0) {
        unsigned* bar = b.bar;
        __builtin_amdgcn_s_waitcnt(0);
        unsigned nloc = b.st[0], nx = b.st[1];
        if (nloc == 0u) { xcd_barrier_complete(bar, b.x, nloc, nx); b.st[0] = nloc; b.st[1] = nx; }
        const unsigned old = xb_add(&bar[XB_XSUB(b.x)], 1u);
        const unsigned gen = old / nloc;
        if (old + 1u == (gen + 1u) * nloc) {
            __builtin_amdgcn_fence(__ATOMIC_RELEASE, "agent");
            asm volatile("s_waitcnt vmcnt(0)" ::: "memory");
            const unsigned og = xb_add(&bar[XB_TOP], 1u);
            const unsigned tg = og / nx;
            if (og + 1u == (tg + 1u) * nx) xb_add(&bar[XB_TOPGEN], 1u);
            else XB_SPIN(xb_ld(&bar[XB_TOPGEN]) == tg, bar);
            __builtin_amdgcn_fence(__ATOMIC_ACQUIRE, "agent");
            xb_add(&bar[XB_XGEN(b.x)], 1u);
            asm volatile("s_waitcnt vmcnt(0)" ::: "memory");
        } else {
            XB_SPIN(xb_ld(&bar[XB_XGEN(b.x)]) == gen, bar);
            __builtin_amdgcn_fence(__ATOMIC_ACQUIRE, "agent");
            asm volatile("s_waitcnt vmcnt(0)" ::: "memory");
        }
    }
    __syncthreads();
}


__device__ __forceinline__ void xcd_split_arrive(const XcdBarrier& b, int id) {
    asm volatile("s_waitcnt vmcnt(0)" ::: "memory");
    __syncthreads();
    if (threadIdx.x == 0) {
        __builtin_amdgcn_s_waitcnt(0);
        const unsigned nloc = b.st[0];
        const unsigned old = xb_add(&b.bar[XB_SSUB(id, b.x)], 1u);
        if (old + 1u == nloc) { __builtin_amdgcn_fence(__ATOMIC_RELEASE, "agent"); asm volatile("s_waitcnt vmcnt(0)" ::: "memory"); xb_add(&b.bar[XB_STOP(id)], 1u); }
    }
}
__device__ __forceinline__ void xcd_split_wait(const XcdBarrier& b, int id) {
    if (threadIdx.x == 0) {
        const unsigned nx = b.st[1];
        XB_SPIN(xb_ld(&b.bar[XB_STOP(id)]) < nx, b.bar);
        __builtin_amdgcn_fence(__ATOMIC_ACQUIRE, "agent");
        asm volatile("s_waitcnt vmcnt(0)" ::: "memory");
    }
    __syncthreads();
}
struct Frame {
    LAS unsigned char* lds;
    volatile LAS unsigned* MISC;
    gu32* ctl;
    int tid, lane, wave;
    int vcu, G;
    const float *xp, *xs, *c128, *c512, *c2048, *state, *w_norm, *w_in, *q_norm, *k_norm, *rel_bias, *ret_norm, *w_pr, *w_pa, *w_out;
    float* out;
    bf16 *Wt_in, *Wt_pr, *Wt_pa, *Wt_out, *XB, *P, *SC, *GA, *GB, *MG;
    float *TB, *L, *OGS, *LS;
    bf16 *OG, *KV;
    f32x2* ROPE;
};

template <bool MAP> __device__ __forceinline__ void p0_transpose_item(const float* W, int K, int N, bf16* WT, int ldw, LAS float* scr, int item, int lane) {
    const int nblk = N / 32, kb = item / nblk, nb = item % nblk, k0 = 64 * kb, n0 = 32 * nb;
    const float wsc = (MAP && n0 >= C_GA) ? -1.4426950408889634f : 1.0f;
    f32x4 x[8];
#pragma unroll
    for (int i = 0; i < 8; ++i) x[i] = __builtin_nontemporal_load((const GAS f32x4*)(W + (size_t)(k0 + 8 * i + (lane >> 3)) * N + n0 + 4 * (lane & 7)));
#pragma unroll
    for (int i = 0; i < 8; ++i) { LAS float* d = scr + (8 * i + (lane >> 3)) * 33 + 4 * (lane & 7); d[0] = x[i].x; d[1] = x[i].y; d[2] = x[i].z; d[3] = x[i].w; }
    LDS_WAIT(); asm volatile("" ::: "memory");
    const int c = lane & 7;
#pragma unroll
    for (int j = 0; j < 4; ++j) { const int n = (lane >> 3) + 8 * j; const LAS float* s = scr + (8 * c) * 33 + n;
        v4u o; o.x = pk2(s[0 * 33] * wsc, s[1 * 33] * wsc); o.y = pk2(s[2 * 33] * wsc, s[3 * 33] * wsc); o.z = pk2(s[4 * 33] * wsc, s[5 * 33] * wsc); o.w = pk2(s[6 * 33] * wsc, s[7 * 33] * wsc);
        const int drow = MAP ? pg8::inproj_rowmap(n0 + n) : (n0 + n);
        *(GAS v4u*)(WT + (size_t)drow * ldw + k0 + 8 * c) = o; }
    LDS_WAIT(); asm volatile("" ::: "memory");
}
__device__ __forceinline__ int t5_bucket(int d) {
    if (d < 16) return d;
    int large = 16 + (int)(log((double)d / 16.0) / log(128.0) * 16.0);
    return large < 31 ? large : 31;
}
__device__ __forceinline__ void p0_prologue(Frame& F) {
    LAS float* scr = (LAS float*)(F.lds + RING_OFF + F.wave * 16384);
    const int gw = F.vcu * NWAVES + F.wave, NGW = F.G * NWAVES;
    { const int e = (gw - 1073) * 64 + F.lane;
      if (gw >= 1073 && e < (129 + 128) * 64) { const int p = e >> 6, j = e & 63; const double inv = pow(10000.0, -(double)j / 64.0);
          const double ang = (p < 129) ? (double)(128 * p) * inv : (double)(p - 129) * inv; F.ROPE[e] = (f32x2){(float)cos(ang), (float)sin(ang)}; } }
    const int gwb = gw - 1024;
    if (gwb >= 0 && gwb * 64 < 24 * 129) {
        float mq = fabsf(F.q_norm[F.lane]), mk = fabsf(F.k_norm[F.lane]), mb = 0.f;
        for (int e = F.lane; e < 32 * 24; e += 64) mb = fmaxf(mb, fabsf(F.rel_bias[e]));
#pragma unroll
        for (int o = 1; o < 64; o <<= 1) { mq = fmaxf(mq, __shfl_xor(mq, o)); mk = fmaxf(mk, __shfl_xor(mk, o)); mb = fmaxf(mb, __shfl_xor(mb, o)); }
        const float Cref = 8.0f * mq * mk + mb;
        const int e = gwb * 64 + F.lane;
        if (e < 24 * 129) { const int gh = e / 129, m = e % 129, g = gh >> 3; const int dil = (g == 0) ? 1 : (g == 1 ? 4 : 16);
            const float tv = (F.rel_bias[t5_bucket(dil * m) * 24 + gh] - Cref) * 1.4426950408889634f;
            F.TB[gh * TB_STRIDE + m] = tv; F.TB[TBG_OFF + gh * TBL_STRIDE + 16 + m] = tv; }
        for (int q = e; q < 24 * 47; q += 49 * 64) { const int gh = q / 47, i = q % 47; F.TB[TBG_OFF + gh * TBL_STRIDE + (i < 16 ? i : 129 + i)] = -1e30f; }
    }
    { const GAS f32x4* gr = (const GAS f32x4*)F.w_norm + F.lane; f32x4 g[4];
#pragma unroll
      for (int j = 0; j < 4; ++j) g[j] = gr[64 * j];
      const bool placed = NGW >= 1362; const int lim = placed ? MP : MR;
      const int nmain = (gw * 4 < lim) ? (lim - gw * 4 + NGW * 4 - 1) / (NGW * 4) : 0;
      const int nst = nmain + ((placed && gw >= 1330 && gw < 1330 + MS / 4) ? 1 : 0);
      for (int s_ = 0; s_ < nst; ++s_) { const int m0 = (s_ < nmain) ? gw * 4 + s_ * NGW * 4 : MP + 4 * (gw - 1330);
        f32x4 v[4][4];
#pragma unroll
        for (int q = 0; q < 4; ++q) { const int m = m0 + q; const float* xrow = (m < MP) ? F.xp + (size_t)m * DM : F.xs + (size_t)(m - MP) * DM; const GAS f32x4* xr = (const GAS f32x4*)xrow + F.lane;
#pragma unroll
            for (int j = 0; j < 4; ++j) v[q][j] = __builtin_nontemporal_load(xr + 64 * j); }
#pragma unroll
        for (int q = 0; q < 4; ++q) { float s = 0.f;
#pragma unroll
            for (int j = 0; j < 4; ++j) s += (v[q][j].x * v[q][j].x + v[q][j].y * v[q][j].y) + (v[q][j].z * v[q][j].z + v[q][j].w * v[q][j].w);
            const float rs = frsq(wave_sum(s) * (1.f / DM) + EPSF);
            GAS unsigned long long* o8 = (GAS unsigned long long*)(F.XB + (size_t)(m0 + q) * DM) + F.lane;
#pragma unroll
            for (int j = 0; j < 4; ++j) { const f32x4 y = v[q][j] * rs * g[j]; o8[64 * j] = (unsigned long long)pk2(y.x, y.y) | ((unsigned long long)pk2(y.z, y.w) << 32); } }
      } }
    constexpr int I_IN = (DM / 64) * (INW / 32), I_PR = (1024 / 64) * (DM / 32), I_PA = (512 / 64) * (DM / 32), I_OUT = (DM / 64) * (DM / 32);
    (void)I_PR; (void)I_PA; (void)I_OUT;
    for (int it = gw; it < I_IN; it += NGW) p0_transpose_item<true>(F.w_in, DM, INW, F.Wt_in, DM, scr, it, F.lane);
}
__device__ __forceinline__ void p1_late_weights(Frame& F, int wfree, int nfree) {
    LAS float* scr = (LAS float*)(F.lds + RING_OFF + F.wave * 16384);
    constexpr int I_PR = (1024 / 64) * (DM / 32), I_PA = (512 / 64) * (DM / 32), I_OUT = (DM / 64) * (DM / 32);
    for (int it = wfree * NWAVES + F.wave; it < I_PR + I_PA + I_OUT; it += nfree * NWAVES) {
        int r = it;
        if (r < I_PR) { p0_transpose_item<false>(F.w_pr, 1024, DM, F.Wt_pr, 1536, scr, r, F.lane); continue; } r -= I_PR;
        if (r < I_PA) { p0_transpose_item<false>(F.w_pa, 512, DM, F.Wt_pr + 1024, 1536, scr, r, F.lane); continue; } r -= I_PA;
        p0_transpose_item<false>(F.w_out, DM, DM, F.Wt_out, DM, scr, r, F.lane);
    }
    __syncthreads();
}

__device__ __forceinline__ void p_touch(Frame& F, const float* p, size_t nfloats) {
    const size_t n4 = nfloats / 4, gt = (size_t)blockIdx.x * 512 + F.tid, NT = (size_t)F.G * 512;
    f32x4 a = (f32x4){0.f, 0.f, 0.f, 0.f};
    for (size_t i = gt; i < n4; i += NT * 8) {
        f32x4 v[8];
#pragma unroll
        for (int j = 0; j < 8; ++j) { const size_t k = i + j * NT; v[j] = (k < n4) ? *(const GAS f32x4*)(p + 4 * k) : (f32x4){0.f, 0.f, 0.f, 0.f}; }
#pragma unroll
        for (int j = 0; j < 8; ++j) a += v[j];
    }
    if (a[0] + a[1] + a[2] + a[3] == 1.2345e-30f) F.TB[3000] = a[0];
}
constexpr int RS_K = 272, RS_V = 528;
__device__ __forceinline__ float head_log2g(int h) { return log2f(1.0f - exp2f(-5.0f - (float)h)); }
struct RkvPre { v4u kx[4], vx[8]; };
__device__ __forceinline__ void ret_kv_load(Frame& F, int u, RkvPre& R) {
    const int c = u & 63, h = (u >> 6) & 3, b = u >> 8, tid = F.tid;
    const bf16* Pr = F.P + (size_t)(b * TP + c * 128) * INW;
#pragma unroll
    for (int it = 0; it < 4; ++it) { const int id = tid + 512 * it, row = id >> 4, ch = id & 15; R.kx[it] = *(const GAS v4u*)(Pr + (size_t)row * INW + C_RK + h * 128 + ch * 8); }
#pragma unroll
    for (int it = 0; it < 8; ++it) { const int id = tid + 512 * it, row = id >> 5, ch = id & 31; R.vx[it] = *(const GAS v4u*)(Pr + (size_t)row * INW + C_RV + h * 256 + ch * 8); }
}
__device__ __forceinline__ void ret_kv_unit(Frame& F, int u, int unext, RkvPre& R) {
    const int h = (u >> 6) & 3;
    const int tid = F.tid, lane = F.lane, w = F.wave;
    LAS unsigned char* ks = F.lds; LAS unsigned char* vs = F.lds + 128 * RS_K;
    const float l2g = head_log2g(h);
    {
#pragma unroll
      for (int it = 0; it < 4; ++it) { const int id = tid + 512 * it, row = id >> 4, ch = id & 15; const v4u x = R.kx[it]; const float kd = fexp2((float)(127 - row) * l2g);
        v4u y; y.x = pk2(bflo(x.x) * kd, bfhi(x.x) * kd); y.y = pk2(bflo(x.y) * kd, bfhi(x.y) * kd); y.z = pk2(bflo(x.z) * kd, bfhi(x.z) * kd); y.w = pk2(bflo(x.w) * kd, bfhi(x.w) * kd);
        *(LAS v4u*)(ks + row * RS_K + ch * 16) = y; }
#pragma unroll
      for (int it = 0; it < 8; ++it) { const int id = tid + 512 * it, row = id >> 5, ch = id & 31; *(LAS v4u*)(vs + row * RS_V + ch * 16) = R.vx[it]; } }
    __syncthreads();
    if (unext >= 0) ret_kv_load(F, unext, R);
    const int g4 = lane >> 4, q4 = (lane & 15) >> 2, p4 = lane & 3, fr = lane & 15;
    f32x4 acc[8][2];
#pragma unroll
    for (int a = 0; a < 8; ++a) { acc[a][0] = (f32x4){0.f, 0.f, 0.f, 0.f}; acc[a][1] = (f32x4){0.f, 0.f, 0.f, 0.f}; }
#pragma unroll
    for (int s = 0; s < 4; ++s) {
        const int t0 = 32 * s + 8 * g4 + q4;
        bf16x8 vf[2];
#pragma unroll
        for (int j = 0; j < 2; ++j) { const LAS unsigned char* a = vs + t0 * RS_V + (32 * w + 16 * j + 4 * p4) * 2; vf[j] = cat8(vtr(a), vtr(a + 4 * RS_V)); }
#pragma unroll
        for (int i0 = 0; i0 < 8; i0 += 4) { s16x4 ka_[4], kb_[4];
#pragma unroll
            for (int i = 0; i < 4; ++i) { const LAS unsigned char* a = ks + t0 * RS_K + (16 * (i0 + i) + 4 * p4) * 2; ka_[i] = vtr(a); kb_[i] = vtr(a + 4 * RS_K); }
#pragma unroll
            for (int i = 0; i < 4; ++i) { const bf16x8 kf = cat8(ka_[i], kb_[i]); acc[i0 + i][0] = MFMA16(kf, vf[0], acc[i0 + i][0]); acc[i0 + i][1] = MFMA16(kf, vf[1], acc[i0 + i][1]); } }
    }
    bf16* dst = F.KV + (size_t)u * 32768;
#pragma unroll
    for (int i = 0; i < 8; i += 2)
#pragma unroll
        for (int j = 0; j < 2; ++j) { unsigned y0x = pk2(acc[i][j][0], acc[i][j][1]), y0y = pk2(acc[i][j][2], acc[i][j][3]), y1x = pk2(acc[i + 1][j][0], acc[i + 1][j][1]), y1y = pk2(acc[i + 1][j][2], acc[i + 1][j][3]);
            { auto r_ = __builtin_amdgcn_permlane16_swap(y0x, y1x, false, false); y0x = r_[0]; y1x = r_[1]; }
            { auto r_ = __builtin_amdgcn_permlane16_swap(y0y, y1y, false, false); y0y = r_[0]; y1y = r_[1]; }
            v4u w4; w4.x = y0x; w4.y = y0y; w4.z = y1x; w4.w = y1y;
            *(GAS v4u*)(dst + (size_t)(32 * w + 16 * j + fr) * 128 + 16 * (i + (g4 & 1)) + 8 * (g4 >> 1)) = w4; }
    __syncthreads();
}

constexpr int RS_A = 144;
constexpr int ATT_ROWS = 272;
constexpr int ATT_UNITS = 3 * NB * 8 * 64;
struct AttnPre { v4u k[5], v[5]; bf16x8 q0, q1; };
__device__ __forceinline__ void attn_decode(int u, int& g, int& b, int& h, int& r, int& j0, int& dil) {
    const int blkcls = u & 63; h = (u >> 6) & 7; b = (u >> 9) & 1; g = u >> 10;
    dil = (g == 0) ? 1 : (g == 1 ? 4 : 16);
    const int nblk = 64 / dil; r = blkcls / nblk; j0 = (blkcls % nblk) * 128;
}
__device__ __forceinline__ void attn_prefetch(Frame& F, int u, AttnPre& R) {
    int g, b, h, r, j0, dil; attn_decode(u, g, b, h, r, j0, dil);
    static_assert(INW * 2 == 5 << 12, "row pitch of P");
    const GAS unsigned char* Pb = (const GAS unsigned char*)(F.P + (size_t)(b * TP) * INW + g * 512 + h * 64);
    const GAS unsigned char* Kb = Pb + C_AK * 2; const GAS unsigned char* Vb = Pb + C_AV * 2; const GAS unsigned char* Qb = Pb + C_AQ * 2;
    const int rr0 = F.tid >> 3, lg = 2 * g; const unsigned lo = (unsigned)(F.tid & 7) * 16u;
#pragma unroll
    for (int it = 0; it < 5; ++it) { int jk = j0 - 128 + rr0 + 64 * it; jk = jk < 0 ? 0 : jk; if (it == 4) jk = jk > j0 + 127 ? j0 + 127 : jk;
        const unsigned rw = (unsigned)(r + (jk << lg)), off = __umul24(rw, (unsigned)(INW * 2)) + lo;        R.k[it] = *(const GAS v4u*)(Kb + off); R.v[it] = *(const GAS v4u*)(Vb + off); }
    { const int tq = r + ((j0 + 16 * F.wave + (F.lane & 15)) << lg); const unsigned tw = (unsigned)tq, off = __umul24(tw, (unsigned)(INW * 2)) + ((unsigned)(F.lane >> 4) * 16u);
      R.q0 = *(const GAS bf16x8*)(Qb + off); R.q1 = *(const GAS bf16x8*)(Qb + off + 64); }
}
template <bool FINAL> __device__ __forceinline__ void attn_unit(Frame& F, int u, int unext, AttnPre& R) {
    int g, b, h, r, j0, dil; attn_decode(u, g, b, h, r, j0, dil);
    const int tid = F.tid, lane = F.lane, w = F.wave, fr = lane & 15, fq = lane >> 4;
    LAS unsigned char* ks = F.lds; LAS unsigned char* vs = F.lds + ATT_ROWS * RS_A; const LAS float* tb = (const LAS float*)(F.lds + 2 * ATT_ROWS * RS_A) + (g * 8 + h) * TBL_STRIDE;
#pragma unroll
    for (int it = 0; it < 5; ++it) { const int id = tid + 512 * it, rr = id >> 3, ch = id & 7;
        if (rr < ATT_ROWS) { *(LAS v4u*)(ks + rr * RS_A + ch * 16) = R.k[it]; *(LAS v4u*)(vs + rr * RS_A + ch * 16) = R.v[it]; } }
    const int tq = r + dil * (j0 + 16 * w + fr);
    const bf16x8 qf0 = R.q0, qf1 = R.q1;
    __syncthreads();
    const int wofs = 16 * (fq & 1) + 8 * (fq >> 1);
    v4u pw1[2], pw2[2], agw[2]; float la = 0.f, lb = 0.f;
    if constexpr (FINAL) { const size_t rowf = (size_t)b * TP + tq;
        const bf16* o1 = F.OG + ((size_t)1 * MP + rowf) * 512 + h * 64 + wofs; const bf16* o2 = F.OG + ((size_t)2 * MP + rowf) * 512 + h * 64 + wofs;
        const bf16* agp = F.P + rowf * INW + C_AG + h * 64 + wofs;
#pragma unroll
        for (int p_ = 0; p_ < 2; ++p_) { pw1[p_] = *(const GAS v4u*)(o1 + 32 * p_); pw2[p_] = *(const GAS v4u*)(o2 + 32 * p_); agw[p_] = *(const GAS v4u*)(agp + 32 * p_); }
        la = F.L[((size_t)1 * MP + rowf) * 8 + h]; lb = F.L[((size_t)2 * MP + rowf) * 8 + h];
        __builtin_amdgcn_sched_barrier(0); }
    if (unext >= 0) attn_prefetch(F, unext, R);
    const LAS float* tbl = tb + (16 + 128 + fr - 4 * fq);
    f32x4 p[10]; float lsum = 0.f;
#pragma unroll
    for (int n0 = 0; n0 < 9; n0 += 3) { bf16x8 k0[3], k1[3]; f32x4 s[3];
#pragma unroll
        for (int j = 0; j < 3; ++j) { const int n = n0 + j; const LAS unsigned char* ka = ks + (16 * w + 16 * n + fr) * RS_A + 16 * fq;
            k0[j] = *(const LAS bf16x8*)(ka); k1[j] = *(const LAS bf16x8*)(ka + 64);
            s[j] = (f32x4){tbl[-16 * n], tbl[-16 * n - 1], tbl[-16 * n - 2], tbl[-16 * n - 3]}; }
#pragma unroll
        for (int j = 0; j < 3; ++j) { s[j] = MFMA16(k0[j], qf0, s[j]); s[j] = MFMA16(k1[j], qf1, s[j]); }
#pragma unroll
        for (int j = 0; j < 3; ++j)
#pragma unroll
            for (int e = 0; e < 4; ++e) p[n0 + j][e] = __builtin_amdgcn_exp2f(s[j][e]);
    }
    if (j0 == 0) {
#pragma unroll
        for (int n = 0; n < 9; ++n)
#pragma unroll
            for (int e = 0; e < 4; ++e) { const int jk = 16 * w + 16 * n + 4 * fq + e - 128; if (jk < 0) p[n][e] = 0.f; }
    }
#pragma unroll
    for (int n = 0; n < 9; ++n) lsum += (p[n][0] + p[n][1]) + (p[n][2] + p[n][3]);
    p[9] = (f32x4){0.f, 0.f, 0.f, 0.f};
    f32x4 o[4];
#pragma unroll
    for (int d = 0; d < 4; ++d) o[d] = (f32x4){0.f, 0.f, 0.f, 0.f};
    const int q4 = (lane & 15) >> 2, p4 = lane & 3;
#pragma unroll
    for (int st = 0; st < 5; ++st) {
        const bf16x8 pf = pack8(p[2 * st][0], p[2 * st][1], p[2 * st][2], p[2 * st][3], p[2 * st + 1][0], p[2 * st + 1][1], p[2 * st + 1][2], p[2 * st + 1][3]);
        const LAS unsigned char* va = vs + (16 * w + 32 * st + 4 * fq + q4) * RS_A + 8 * p4;
        s16x4 va_[4], vb_[4];
#pragma unroll
        for (int d = 0; d < 4; ++d) { va_[d] = vtr(va + 32 * d); vb_[d] = vtr(va + 16 * RS_A + 32 * d); }
#pragma unroll
        for (int d = 0; d < 4; ++d) o[d] = MFMA16(cat8(va_[d], vb_[d]), pf, o[d]);
    }
    lsum += __shfl_xor(lsum, 16); lsum += __shfl_xor(lsum, 32);
    const size_t row = (size_t)b * TP + tq;
#define PSWAP(a_, b_) do { auto r_ = __builtin_amdgcn_permlane16_swap((a_), (b_), false, false); (a_) = r_[0]; (b_) = r_[1]; } while (0)
    if constexpr (!FINAL) {
        bf16* og = F.OG + ((size_t)g * MP + row) * 512 + h * 64 + wofs;
#pragma unroll
        for (int p_ = 0; p_ < 2; ++p_) { unsigned y0x = pk2(o[2 * p_][0], o[2 * p_][1]), y0y = pk2(o[2 * p_][2], o[2 * p_][3]), y1x = pk2(o[2 * p_ + 1][0], o[2 * p_ + 1][1]), y1y = pk2(o[2 * p_ + 1][2], o[2 * p_ + 1][3]);
            PSWAP(y0x, y1x); PSWAP(y0y, y1y);
            v4u w4; w4.x = y0x; w4.y = y0y; w4.z = y1x; w4.w = y1y; *(GAS v4u*)(og + 32 * p_) = w4; }
        if (fq == 0) F.L[((size_t)g * MP + row) * 8 + h] = lsum;
    } else {
        const float lt = lsum + la + lb;
        const float il = frcp(lt);
        bf16* gb = F.GA + row * 1536 + 1024 + h * 64 + wofs;
#pragma unroll
        for (int p_ = 0; p_ < 2; ++p_) {
            unsigned a1x = pw1[p_].x, a1y = pw1[p_].y, b1x = pw1[p_].z, b1y = pw1[p_].w; PSWAP(a1x, b1x); PSWAP(a1y, b1y);
            unsigned a2x = pw2[p_].x, a2y = pw2[p_].y, b2x = pw2[p_].z, b2y = pw2[p_].w; PSWAP(a2x, b2x); PSWAP(a2y, b2y);
            unsigned agx = agw[p_].x, agy = agw[p_].y, bgx = agw[p_].z, bgy = agw[p_].w; PSWAP(agx, bgx); PSWAP(agy, bgy);
            const int d0 = 2 * p_, d1 = 2 * p_ + 1;
            unsigned y0x = pk2((o[d0][0] + bflo(a1x) + bflo(a2x)) * il * bflo(agx), (o[d0][1] + bfhi(a1x) + bfhi(a2x)) * il * bfhi(agx));
            unsigned y0y = pk2((o[d0][2] + bflo(a1y) + bflo(a2y)) * il * bflo(agy), (o[d0][3] + bfhi(a1y) + bfhi(a2y)) * il * bfhi(agy));
            unsigned y1x = pk2((o[d1][0] + bflo(b1x) + bflo(b2x)) * il * bflo(bgx), (o[d1][1] + bfhi(b1x) + bfhi(b2x)) * il * bfhi(bgx));
            unsigned y1y = pk2((o[d1][2] + bflo(b1y) + bflo(b2y)) * il * bflo(bgy), (o[d1][3] + bfhi(b1y) + bfhi(b2y)) * il * bfhi(bgy));
            PSWAP(y0x, y1x); PSWAP(y0y, y1y);
            v4u w4; w4.x = y0x; w4.y = y0y; w4.z = y1x; w4.w = y1y; *(GAS v4u*)(gb + 32 * p_) = w4; }
    }
#undef PSWAP
    __syncthreads();
}
template <bool FINAL> __device__ __forceinline__ void attn_phase(Frame& F, int ubase, int nunits, int nall, int nextra) {
    AttnPre R;
    { LAS f32x4* tb = (LAS f32x4*)(F.lds + 2 * ATT_ROWS * RS_A);
      const GAS f32x4* src = (const GAS f32x4*)(F.TB + TBG_OFF); f32x4 tv[3];
#pragma unroll
      for (int j = 0; j < 3; ++j) { const int i = F.tid + 512 * j; tv[j] = (i < 24 * TBL_STRIDE / 4) ? src[i] : (f32x4){0.f, 0.f, 0.f, 0.f}; }
#pragma unroll
      for (int j = 0; j < 3; ++j) { const int i = F.tid + 512 * j; if (i < 24 * TBL_STRIDE / 4) tb[i] = tv[j]; } }
    if (F.G == 256) {
        const int nk = nall + ((F.vcu >= 128) ? nextra : 0);
#define ATT_UK(k) (ubase + (((k) < nall) ? F.vcu + 256 * (k) : 256 * nall + (F.vcu - 128) + 128 * ((k) - nall)))
        AttnPre R2;
        if (nk > 0) attn_prefetch(F, ATT_UK(0), R);
        if (nk > 1) attn_prefetch(F, ATT_UK(1), R2);
        for (int k = 0; k < nk; k += 2) {
            attn_unit<FINAL>(F, ATT_UK(k), (k + 2 < nk) ? ATT_UK(k + 2) : -1, R);
            if (k + 1 < nk) attn_unit<FINAL>(F, ATT_UK(k + 1), (k + 3 < nk) ? ATT_UK(k + 3) : -1, R2);
        }
#undef ATT_UK
        return;
    }
    int u = F.vcu;
    if (u < nunits) attn_prefetch(F, ubase + u, R);
    for (; u < nunits; u += F.G) { const int un = (u + F.G < nunits) ? ubase + u + F.G : -1; attn_unit<FINAL>(F, ubase + u, un, R); }
}

template <int CTRL> __device__ __forceinline__ float dpp_f(float v) { return __builtin_bit_cast(float, __builtin_amdgcn_update_dpp(0, __builtin_bit_cast(int, v), CTRL, 0xf, 0xf, true)); }
__device__ __forceinline__ void samp_attn_unit(Frame& F, int u, int zl = 0) {
    const int half = u & 1, i = (u >> 1) & 3, b = u >> 3;
    const int w = F.wave, lane = F.lane + zl, hd = lane >> 3;
    const size_t srow = (size_t)b * ST + i;
    const bf16* pr = F.P + ((size_t)MP + srow) * INW;
    const float* c0 = F.c128; const float* c1 = F.c512; const float* c2 = F.c2048;
    const float* n0 = F.out + O_KVS0; const float* n1 = F.out + O_KVS1; const float* n2 = F.out + O_KVS2;
    f32x4 q[3][2];
#pragma unroll
    for (int g = 0; g < 3; ++g) { const v4u qw = *(const GAS v4u*)(pr + C_AQ + g * 512 + lane * 8);
        q[g][0] = (f32x4){bflo(qw.x), bfhi(qw.x), bflo(qw.y), bfhi(qw.y)}; q[g][1] = (f32x4){bflo(qw.z), bfhi(qw.z), bflo(qw.w), bfhi(qw.w)}; }
    f32x4 o0 = (f32x4){0.f, 0.f, 0.f, 0.f}, o1 = o0; float l = 0.f;
#pragma unroll 4
    for (int it = 0; it < 25; ++it) {
        const int pidx = half + 2 * w + 16 * it; const bool ok = pidx < 387; const int pc = ok ? pidx : 386;
        const int g = (pc >= 258) ? 2 : (pc >= 129 ? 1 : 0), m = pc - 129 * g;
        const int W = (g == 0) ? 128 : (g == 1 ? 512 : 2048), dil = (g == 0) ? 1 : (g == 1 ? 4 : 16);
        const int e = W + i - dil * m;
        const float* cg = (g == 0) ? c0 : (g == 1 ? c1 : c2); const float* ng = (g == 0) ? n0 : (g == 1 ? n1 : n2);
        const float* kr = ((e < W) ? cg + ((size_t)(b * W + e) * 2) * 512 : ng + ((size_t)(b * ST + (e - W)) * 2) * 512) + lane * 8;
        const f32x4 k0 = __builtin_nontemporal_load((const GAS f32x4*)kr), k1 = __builtin_nontemporal_load((const GAS f32x4*)(kr + 4)), v0 = __builtin_nontemporal_load((const GAS f32x4*)(kr + 512)), v1 = __builtin_nontemporal_load((const GAS f32x4*)(kr + 516));
        const float tbv = F.TB[(g * 8 + hd) * TB_STRIDE + m];
        const f32x4 qa = (g == 0) ? q[0][0] : (g == 1 ? q[1][0] : q[2][0]), qb = (g == 0) ? q[0][1] : (g == 1 ? q[1][1] : q[2][1]);
        float d = ((k0.x * qa.x + k0.y * qa.y) + (k0.z * qa.z + k0.w * qa.w)) + ((k1.x * qb.x + k1.y * qb.y) + (k1.z * qb.z + k1.w * qb.w));
        d += __shfl_xor(d, 1); d += __shfl_xor(d, 2); d += __shfl_xor(d, 4);
        const float p = ok ? __builtin_amdgcn_exp2f(d + tbv) : 0.f;
        o0 += v0 * p; o1 += v1 * p; l += p;
    }
    LAS float* xb = (LAS float*)F.lds;
    { LAS float* x = xb + (w * 64 + lane) * 9; x[0] = o0[0]; x[1] = o0[1]; x[2] = o0[2]; x[3] = o0[3]; x[4] = o1[0]; x[5] = o1[1]; x[6] = o1[2]; x[7] = o1[3]; x[8] = l; }
    __syncthreads();
    if (w == 0) { float s[9];
#pragma unroll
        for (int e = 0; e < 9; ++e) s[e] = 0.f;
#pragma unroll
        for (int ww = 0; ww < 8; ++ww) { const LAS float* x = xb + (ww * 64 + lane) * 9;
#pragma unroll
            for (int e = 0; e < 9; ++e) s[e] += x[e]; }
        float* og = F.OGS + ((size_t)half * MS + srow) * 512 + lane * 8;
        *(GAS f32x4*)og = (f32x4){s[0], s[1], s[2], s[3]}; *(GAS f32x4*)(og + 4) = (f32x4){s[4], s[5], s[6], s[7]};
        if ((lane & 7) == 0) F.LS[((size_t)half * MS + srow) * 8 + hd] = s[8]; }
    __syncthreads();
}

__device__ __forceinline__ void samp_ret_unit(Frame& F, int u) {
    const int b = u >> 2, h = u & 3, tid = F.tid;
    LAS float* qs = (LAS float*)F.lds;
    LAS float* ksm = qs + 512;
    LAS float* vsm = ksm + 512;
    LAS float* sc = vsm + 1024;
    LAS float* red = sc + 16;
    LAS float* st = red + 2048;
    const size_t row0 = (size_t)MP + b * ST;
    const float gam = 1.0f - exp2f(-5.0f - (float)h);
    { const int i = tid >> 7, d = tid & 127; const bf16* pr = F.P + (row0 + i) * INW; qs[tid] = bf2f(pr[C_RQ + h * 128 + d]); ksm[tid] = bf2f(pr[C_RK + h * 128 + d]); }
    for (int e = tid; e < 1024; e += 512) { const int i = e >> 8, d = e & 255; vsm[e] = bf2f(F.P[(row0 + i) * INW + C_RV + h * 256 + d]); }
    __syncthreads();
    if (tid < 16) { const int i = tid >> 2, j = tid & 3; float s = 0.f; for (int d = 0; d < 128; ++d) s += qs[i * 128 + d] * ksm[j * 128 + d]; sc[tid] = (j <= i) ? s * powf(gam, (float)(i - j)) : 0.f; }
    const int dv = tid & 255, half = tid >> 8;
    const float g1 = gam, g2 = gam * gam, g3 = g2 * gam, g4 = g2 * g2;
    float acc[4] = {0.f, 0.f, 0.f, 0.f};
    const float v0 = vsm[dv], v1 = vsm[256 + dv], v2 = vsm[512 + dv], v3 = vsm[768 + dv];
    const float* s0p = F.state + ((size_t)(b * 4 + h) * 128) * 256 + dv; float* snp = F.out + O_RSS + ((size_t)(b * 4 + h) * 128) * 256 + dv;
#pragma unroll 1
    for (int k0 = 0; k0 < 64; k0 += 16) { float sv[16];
#pragma unroll
        for (int k = 0; k < 16; ++k) sv[k] = __builtin_nontemporal_load(s0p + (size_t)(half * 64 + k0 + k) * 256);
#pragma unroll
        for (int k = 0; k < 16; ++k) { const int dk = half * 64 + k0 + k; const float s0 = sv[k];
            acc[0] += qs[dk] * s0; acc[1] += qs[128 + dk] * s0; acc[2] += qs[256 + dk] * s0; acc[3] += qs[384 + dk] * s0;
            __builtin_nontemporal_store(g4 * s0 + g3 * ksm[dk] * v0 + g2 * ksm[128 + dk] * v1 + g1 * ksm[256 + dk] * v2 + ksm[384 + dk] * v3, snp + (size_t)dk * 256); } }
#pragma unroll
    for (int i = 0; i < 4; ++i) red[(half * 4 + i) * 256 + dv] = acc[i];
    __syncthreads();
    float ov[2];
#pragma unroll
    for (int ii = 0; ii < 2; ++ii) { const int i = 2 * half + ii; float o = powf(gam, (float)(i + 1)) * (red[i * 256 + dv] + red[(4 + i) * 256 + dv]);
        o += sc[i * 4 + 0] * v0 + sc[i * 4 + 1] * v1 + sc[i * 4 + 2] * v2 + sc[i * 4 + 3] * v3; ov[ii] = o; }
    const int wv = F.wave;
    { const float s0 = wave_sum(ov[0]), s1 = wave_sum(ov[1]); if (F.lane == 0) { st[wv * 4 + 0] = s0; st[wv * 4 + 1] = s1; } }
    __syncthreads();
    const int wb = half * 4;
    const float mean0 = (st[(wb + 0) * 4 + 0] + st[(wb + 1) * 4 + 0] + st[(wb + 2) * 4 + 0] + st[(wb + 3) * 4 + 0]) * (1.f / 256.f);
    const float mean1 = (st[(wb + 0) * 4 + 1] + st[(wb + 1) * 4 + 1] + st[(wb + 2) * 4 + 1] + st[(wb + 3) * 4 + 1]) * (1.f / 256.f);
    const float d0 = ov[0] - mean0, d1 = ov[1] - mean1;
    { const float s0 = wave_sum(d0 * d0), s1 = wave_sum(d1 * d1); if (F.lane == 0) { st[wv * 4 + 2] = s0; st[wv * 4 + 3] = s1; } }
    __syncthreads();
    const float var0 = (st[(wb + 0) * 4 + 2] + st[(wb + 1) * 4 + 2] + st[(wb + 2) * 4 + 2] + st[(wb + 3) * 4 + 2]) * (1.f / 256.f);
    const float var1 = (st[(wb + 0) * 4 + 3] + st[(wb + 1) * 4 + 3] + st[(wb + 2) * 4 + 3] + st[(wb + 3) * 4 + 3]) * (1.f / 256.f);
    const float gn = F.ret_norm[h * 256 + dv];
#pragma unroll
    for (int ii = 0; ii < 2; ++ii) { const int i = 2 * half + ii; const float y = (ii == 0 ? d0 : d1) * (1.0f / sqrtf((ii == 0 ? var0 : var1) + EPSF)) * gn;
        const float rg = bf2f(F.P[(row0 + i) * INW + C_RG + h * 256 + dv]);
        F.GA[(row0 + i) * 1536 + h * 256 + dv] = (bf16)f2bf(rg * y); }
    __syncthreads();
}

__device__ __forceinline__ void p4_scan_combine(Frame& F) {
    const int gt = blockIdx.x * (NWAVES * 64) + F.tid, NGT = F.G * NWAVES * 64;
    for (int e2 = gt; e2 < 8 * 16384; e2 += NGT) {
        const int bh = e2 >> 14, idx = (e2 & 16383) * 2, h = bh & 3;
        const float gam = 1.0f - exp2f(-5.0f - (float)h); const float cd = powf(gam, 128.0f);
        const bf16* kv = F.KV + (size_t)bh * 64 * 32768 + idx; bf16* sc = F.SC + (size_t)bh * 64 * 32768 + idx;
        float s0 = 0.f, s1 = 0.f;
#pragma unroll 1
        for (int c0 = 0; c0 < NCH; c0 += 16) { unsigned kq[16];
#pragma unroll
            for (int c = 0; c < 16; ++c) kq[c] = *(const GAS unsigned*)(kv + (size_t)(c0 + c) * 32768);
#pragma unroll
            for (int c = 0; c < 16; ++c) { *(GAS unsigned*)(sc + (size_t)(c0 + c) * 32768) = pk2(s0, s1); s0 = s0 * cd + bflo(kq[c]); s1 = s1 * cd + bfhi(kq[c]); } }
        const int dv = idx >> 7, dk = idx & 127;
        float* o = F.out + O_RSP + (size_t)bh * 32768; o[(size_t)dk * 256 + dv] = s0; o[(size_t)(dk + 1) * 256 + dv] = s1;
    }
}
__device__ __forceinline__ void p4_samp_combine(Frame& F) {
    const int gw = F.vcu * NWAVES + F.wave, NGW = F.G * NWAVES, lane = F.lane;
    for (int s = gw; s < MS; s += NGW) {
        const int hh = lane >> 3; const float il = 1.0f / (F.LS[(size_t)s * 8 + hh] + F.LS[((size_t)MS + s) * 8 + hh]);
        const float* p0 = F.OGS + (size_t)s * 512 + lane * 8; const float* p1 = p0 + (size_t)MS * 512;
        const f32x4 a0 = *(const GAS f32x4*)p0 + *(const GAS f32x4*)p1, a1 = *(const GAS f32x4*)(p0 + 4) + *(const GAS f32x4*)(p1 + 4);
        const size_t r = (size_t)MP + s;
        const v4u agw = *(const GAS v4u*)(F.P + r * INW + C_AG + lane * 8);
        v4u w; w.x = pk2(bflo(agw.x) * a0[0] * il, bfhi(agw.x) * a0[1] * il); w.y = pk2(bflo(agw.y) * a0[2] * il, bfhi(agw.y) * a0[3] * il);
        w.z = pk2(bflo(agw.z) * a1[0] * il, bfhi(agw.z) * a1[1] * il); w.w = pk2(bflo(agw.w) * a1[2] * il, bfhi(agw.w) * a1[3] * il);
        *(GAS v4u*)(F.GA + r * 1536 + 1024 + lane * 8) = w;
    }
}

template <bool MERGE>
__device__ __forceinline__ void samp_micro_unit(Frame& F, int u) {
    const int lane = F.lane, w = F.wave, fr = lane & 15, fq = lane >> 4, tid = F.tid;
    const int rt = u & 7, cs = u >> 3;
    constexpr int K = MERGE ? 1536 : 1024;
    const bf16* Ap = (MERGE ? F.GA : F.MG) + (size_t)(MP + 16 * rt + fr) * K + 8 * fq + 128 * w;
    const bf16* Bp = (MERGE ? F.Wt_pr : F.Wt_out) + (size_t)(32 * cs + fr) * K + 8 * fq + 128 * w;
    v4u af[4], b0[4], b1[4];
#pragma unroll
    for (int s = 0; s < 4; ++s) { af[s] = *(const GAS v4u*)(Ap + 32 * s); b0[s] = *(const GAS v4u*)(Bp + 32 * s); b1[s] = *(const GAS v4u*)(Bp + (size_t)16 * K + 32 * s); }
    v4u ag[2], c0[2], c1[2]; unsigned gw[4]; f32x4 xr;
    if constexpr (MERGE) {
        const bf16* Aq = Ap - 128 * w + 1024 + 64 * w; const bf16* Bq = Bp - 128 * w + 1024 + 64 * w;
#pragma unroll
        for (int s = 0; s < 2; ++s) { ag[s] = *(const GAS v4u*)(Aq + 32 * s); c0[s] = *(const GAS v4u*)(Bq + 32 * s); c1[s] = *(const GAS v4u*)(Bq + (size_t)16 * K + 32 * s); }
        const unsigned char* gp = (const unsigned char*)F.P + (size_t)(MP + 16 * rt + fr) * (INW * 2) + GATE_OFF + 32 * cs + 4 * fq;
        gw[0] = *(const GAS unsigned*)gp; gw[1] = *(const GAS unsigned*)(gp + 16); gw[2] = *(const GAS unsigned*)(gp + 1024); gw[3] = *(const GAS unsigned*)(gp + 1040);
    } else {
        if (tid < 128) xr = *(const GAS f32x4*)(F.xs + (size_t)(16 * rt + fr) * DM + 32 * cs + 16 * (tid >> 6) + 4 * fq);
    }
    f32x4 a0 = (f32x4){0.f, 0.f, 0.f, 0.f}, a1 = a0;
#pragma unroll
    for (int s = 0; s < 4; ++s) { const bf16x8 y = __builtin_bit_cast(bf16x8, af[s]); a0 = MFMA16(__builtin_bit_cast(bf16x8, b0[s]), y, a0); a1 = MFMA16(__builtin_bit_cast(bf16x8, b1[s]), y, a1); }
    if constexpr (MERGE) {
        f32x4 e0 = (f32x4){0.f, 0.f, 0.f, 0.f}, e1 = e0;
#pragma unroll
        for (int s = 0; s < 2; ++s) { const bf16x8 y = __builtin_bit_cast(bf16x8, ag[s]); e0 = MFMA16(__builtin_bit_cast(bf16x8, c0[s]), y, e0); e1 = MFMA16(__builtin_bit_cast(bf16x8, c1[s]), y, e1); }
#pragma unroll
        for (int r = 0; r < 4; ++r) {
            a0[r] = (a0[r] * (float)((gw[0] >> (8 * r)) & 0xffu) + e0[r] * (float)((gw[2] >> (8 * r)) & 0xffu)) * (1.0f / 255.0f);
            a1[r] = (a1[r] * (float)((gw[1] >> (8 * r)) & 0xffu) + e1[r] * (float)((gw[3] >> (8 * r)) & 0xffu)) * (1.0f / 255.0f); }
    }
    LAS unsigned char* red = F.lds;
    *(LAS f32x4*)(red + ((w * 2 + 0) * 64 + lane) * 16) = a0;
    *(LAS f32x4*)(red + ((w * 2 + 1) * 64 + lane) * 16) = a1;
    __syncthreads();
    if (tid < 128) {
        const int t = tid >> 6;
        f32x4 sm = *(const LAS f32x4*)(red + (t * 64 + lane) * 16);
#pragma unroll
        for (int ww = 1; ww < 8; ++ww) sm += *(const LAS f32x4*)(red + ((ww * 2 + t) * 64 + lane) * 16);
        const size_t o = (size_t)(MP + 16 * rt + fr) * DM + 32 * cs + 16 * t + 4 * fq;
        if constexpr (MERGE) { v2u y; y.x = pk2(sm[0], sm[1]); y.y = pk2(sm[2], sm[3]); *(GAS v2u*)(F.MG + o) = y; }
        else { *(GAS f32x4*)(F.out + o) = xr + sm; }
    }
    __syncthreads();
}

__device__ __forceinline__ void ret_out_unit(Frame& F, int u) {
    const int c = u & 63, h = (u >> 6) & 3, b = u >> 8;
    const int tid = F.tid, lane = F.lane, w = F.wave, fr = lane & 15, fq = lane >> 4;
    LAS unsigned char* ks = F.lds; LAS unsigned char* vs = F.lds + 128 * RS_K; LAS unsigned char* s0 = vs + 128 * RS_V;
    const size_t row0 = (size_t)b * TP + c * 128;
    const bf16* Pr = F.P + row0 * INW;
    const bf16* scg = F.SC + (size_t)u * 32768;
    const float l2g = head_log2g(h);
    v4u s1r[4];
    { v4u kx[4], s0x[4], vx[8];
#pragma unroll
      for (int it = 0; it < 4; ++it) { const int id = tid + 512 * it, row = id >> 4, ch = id & 15;
        kx[it] = *(const GAS v4u*)(Pr + (size_t)row * INW + C_RK + h * 128 + ch * 8); s0x[it] = *(const GAS v4u*)(scg + (size_t)row * 128 + ch * 8); s1r[it] = *(const GAS v4u*)(scg + (size_t)(128 + row) * 128 + ch * 8); }
#pragma unroll
      for (int it = 0; it < 8; ++it) { const int id = tid + 512 * it, row = id >> 5, ch = id & 31; vx[it] = *(const GAS v4u*)(Pr + (size_t)row * INW + C_RV + h * 256 + ch * 8); }
#pragma unroll
      for (int it = 0; it < 4; ++it) { const int id = tid + 512 * it, row = id >> 4, ch = id & 15; *(LAS v4u*)(ks + row * RS_K + ch * 16) = kx[it]; *(LAS v4u*)(s0 + row * RS_K + ch * 16) = s0x[it]; }
#pragma unroll
      for (int it = 0; it < 8; ++it) { const int id = tid + 512 * it, row = id >> 5, ch = id & 31; *(LAS v4u*)(vs + row * RS_V + ch * 16) = vx[it]; } }
    if (tid < 256) ((LAS float*)(F.lds + 137216))[tid] = F.ret_norm[h * 256 + tid];
    const int tq = 16 * w + fr;
    const bf16* qp = Pr + (size_t)tq * INW + C_RQ + h * 128 + 8 * fq;
    bf16x8 qf[4], qd[4];
    const float qdec = fexp2((float)(tq + 1) * l2g);
#pragma unroll
    for (int s = 0; s < 4; ++s) { const v4u x = *(const GAS v4u*)(qp + 32 * s); qf[s] = __builtin_bit_cast(bf16x8, x);
        v4u y; y.x = pk2(bflo(x.x) * qdec, bfhi(x.x) * qdec); y.y = pk2(bflo(x.y) * qdec, bfhi(x.y) * qdec); y.z = pk2(bflo(x.z) * qdec, bfhi(x.z) * qdec); y.w = pk2(bflo(x.w) * qdec, bfhi(x.w) * qdec);
        qd[s] = __builtin_bit_cast(bf16x8, y); }
    __syncthreads();
    f32x4 pt[8];
#pragma unroll
    for (int n = 0; n < 8; ++n) {
        f32x4 sa = (f32x4){0.f, 0.f, 0.f, 0.f};
        if (n <= w) {
            const LAS unsigned char* ka = ks + (16 * n + fr) * RS_K + 16 * fq;
            bf16x8 kf[4];
#pragma unroll
            for (int kk = 0; kk < 4; ++kk) kf[kk] = *(const LAS bf16x8*)(ka + 64 * kk);
#pragma unroll
            for (int kk = 0; kk < 4; ++kk) sa = MFMA16(kf[kk], qf[kk], sa);
#pragma unroll
            for (int e = 0; e < 4; ++e) { const int diff = tq - (16 * n + 4 * fq + e); sa[e] = (diff >= 0) ? sa[e] * fexp2((float)diff * l2g) : 0.f; }
        }
        pt[n] = sa;
    }
    __syncthreads();
#pragma unroll
    for (int it = 0; it < 4; ++it) { const int id = tid + 512 * it, row = id >> 4, ch = id & 15; *(LAS v4u*)(ks + row * RS_K + ch * 16) = s1r[it]; }
    f32x4 o[16];
#pragma unroll
    for (int d = 0; d < 16; ++d) o[d] = (f32x4){0.f, 0.f, 0.f, 0.f};
    const int q4 = (lane & 15) >> 2, p4 = lane & 3;
#pragma unroll
    for (int st = 0; st < 4; ++st) {
        if (2 * st <= w) {
            const bf16x8 pf = pack8(pt[2 * st][0], pt[2 * st][1], pt[2 * st][2], pt[2 * st][3], pt[2 * st + 1][0], pt[2 * st + 1][1], pt[2 * st + 1][2], pt[2 * st + 1][3]);
            const LAS unsigned char* va = vs + (32 * st + 4 * fq + q4) * RS_V + 8 * p4;
#pragma unroll
            for (int d0 = 0; d0 < 16; d0 += 4) { s16x4 va_[4], vb_[4];
#pragma unroll
                for (int d = 0; d < 4; ++d) { va_[d] = vtr(va + 32 * (d0 + d)); vb_[d] = vtr(va + 16 * RS_V + 32 * (d0 + d)); }
#pragma unroll
                for (int d = 0; d < 4; ++d) o[d0 + d] = MFMA16(cat8(va_[d], vb_[d]), pf, o[d0 + d]); }
        }
    }
    v4u rgw[8];
    { const bf16* rgp_ = Pr + (size_t)tq * INW + C_RG + h * 256 + 16 * (fq & 1) + 8 * (fq >> 1);
#pragma unroll
      for (int p = 0; p < 8; ++p) rgw[p] = *(const GAS v4u*)(rgp_ + 32 * p); }
    __builtin_amdgcn_sched_barrier(0);
    __syncthreads();
#pragma unroll
    for (int d0 = 0; d0 < 16; d0 += 2) { bf16x8 sf[2][4];
#pragma unroll
        for (int d = 0; d < 2; ++d) { const LAS unsigned char* sa = ((d0 + d < 8) ? s0 : ks) + (16 * ((d0 + d) & 7) + fr) * RS_K + 16 * fq;
#pragma unroll
            for (int s = 0; s < 4; ++s) sf[d][s] = *(const LAS bf16x8*)(sa + 64 * s); }
#pragma unroll
        for (int d = 0; d < 2; ++d)
#pragma unroll
            for (int s = 0; s < 4; ++s) o[d0 + d] = MFMA16(sf[d][s], qd[s], o[d0 + d]); }
    float sm = 0.f;
#pragma unroll
    for (int d = 0; d < 16; ++d) sm += (o[d][0] + o[d][1]) + (o[d][2] + o[d][3]);
    sm += __shfl_xor(sm, 16); sm += __shfl_xor(sm, 32);
    const float mean = sm * (1.f / 256.f); float vq = 0.f;
#pragma unroll
    for (int d = 0; d < 16; ++d) { o[d] = o[d] - mean; vq += (o[d][0] * o[d][0] + o[d][1] * o[d][1]) + (o[d][2] * o[d][2] + o[d][3] * o[d][3]); }
    vq += __shfl_xor(vq, 16); vq += __shfl_xor(vq, 32);
    const float rstd = frsq(vq * (1.f / 256.f) + EPSF);
    const LAS float* gnl = (const LAS float*)(F.lds + 137216) + 4 * fq;
    bf16* gap = F.GA + (row0 + tq) * 1536 + h * 256 + 16 * (fq & 1) + 8 * (fq >> 1);
#pragma unroll
    for (int p = 0; p < 8; ++p) {
        unsigned ax = rgw[p].x, ay = rgw[p].y, bx = rgw[p].z, by = rgw[p].w;
        { auto r_ = __builtin_amdgcn_permlane16_swap(ax, bx, false, false); ax = r_[0]; bx = r_[1]; }
        { auto r_ = __builtin_amdgcn_permlane16_swap(ay, by, false, false); ay = r_[0]; by = r_[1]; }
        unsigned yy[2][2];
#pragma unroll
        for (int j = 0; j < 2; ++j) { const int d = 2 * p + j; const unsigned rx = j ? bx : ax, ry = j ? by : ay; const f32x4 gn = *(const LAS f32x4*)(gnl + 16 * d);
            yy[j][0] = pk2(o[d][0] * rstd * gn.x * bflo(rx), o[d][1] * rstd * gn.y * bfhi(rx));
            yy[j][1] = pk2(o[d][2] * rstd * gn.z * bflo(ry), o[d][3] * rstd * gn.w * bfhi(ry)); }
        { auto r_ = __builtin_amdgcn_permlane16_swap(yy[0][0], yy[1][0], false, false); yy[0][0] = r_[0]; yy[1][0] = r_[1]; }
        { auto r_ = __builtin_amdgcn_permlane16_swap(yy[0][1], yy[1][1], false, false); yy[0][1] = r_[0]; yy[1][1] = r_[1]; }
        v4u w4; w4.x = yy[0][0]; w4.y = yy[0][1]; w4.z = yy[1][0]; w4.w = yy[1][1];
        *(GAS v4u*)(gap + 32 * p) = w4; }
    __syncthreads();
}
#ifndef MK_N_LAUNCHES
#define MK_N_LAUNCHES 1
#endif
constexpr int N_PHASES = 9;
#ifndef DBL
#define DBL 0
#endif
#ifndef REP_PHASE
#define REP_PHASE -1
#endif
struct Args { const float* in[15]; float* out; unsigned char* ws; int ph_lo, ph_hi, use_bar, pad; };
__global__ void __launch_bounds__(NWAVES * 64, 2) mk_fwd(Args args) {
    extern __shared__ __attribute__((aligned(16))) unsigned char lds[];
    Frame F;
    F.lds = (LAS unsigned char*)lds;
    F.MISC = (volatile LAS unsigned*)(F.lds + MISC_OFF);
    F.tid = threadIdx.x; F.lane = F.tid & 63; F.wave = __builtin_amdgcn_readfirstlane(F.tid >> 6);
    F.G = gridDim.x; { const int bx = blockIdx.x; F.vcu = (F.G % 8 == 0) ? (bx % 8) * (F.G / 8) + bx / 8 : bx; }
    unsigned char* ws = args.ws;
    F.ctl = (gu32*)(ws + WS_CTL);
    F.xp = args.in[0]; F.xs = args.in[1]; F.c128 = args.in[2]; F.c512 = args.in[3]; F.c2048 = args.in[4]; F.state = args.in[5]; F.w_norm = args.in[6]; F.w_in = args.in[7];
    F.q_norm = args.in[8]; F.k_norm = args.in[9]; F.rel_bias = args.in[10]; F.ret_norm = args.in[11]; F.w_pr = args.in[12]; F.w_pa = args.in[13]; F.w_out = args.in[14];
    F.out = args.out;
    F.Wt_in = (bf16*)(ws + WS_WIN); F.Wt_pr = (bf16*)(ws + WS_WPR); F.Wt_pa = (bf16*)(ws + WS_WPA); F.Wt_out = (bf16*)(ws + WS_WOUT);
    F.XB = (bf16*)(ws + WS_XB); F.P = (bf16*)(ws + WS_P); F.SC = (bf16*)(ws + WS_SC); F.GA = (bf16*)(ws + WS_GA); F.GB = (bf16*)(ws + WS_GB); F.MG = (bf16*)(ws + WS_MG);
    F.TB = (float*)(ws + WS_TB); F.KV = (bf16*)(ws + WS_KV); F.OGS = (float*)(ws + WS_OGS); F.LS = (float*)(ws + WS_LS); F.OG = (bf16*)(ws + WS_OG); F.L = (float*)(ws + WS_L); F.ROPE = (f32x2*)(ws + WS_ROPE);
    for (int u = F.tid; u < (LDS_BYTES - LDSCTL_OFF) / 4; u += NWAVES * 64) ((LAS unsigned*)(F.lds + LDSCTL_OFF))[u] = 0u;
    __syncthreads();
    XcdBarrier bar; bar.bar = (unsigned*)(F.ctl + CW_BAR); bar.x = 0; bar.st = nullptr;
    if (args.use_bar) bar = xcd_barrier_post((unsigned*)(F.ctl + CW_BAR), F.MISC + 8);
    const int lo = args.ph_lo, hi = args.ph_hi;
#define IN(k) (lo <= (k) && (k) < hi)
#if REP_PHASE == 99
#define SEAM(k) do { if (IN(k) && ((k) + 1 < hi)) { xcd_barrier(bar); xcd_barrier(bar); } } while (0)
#else
#define SEAM(k) do { if (IN(k) && ((k) + 1 < hi)) xcd_barrier(bar); } while (0)
#endif

#ifndef P1_ROT
#define P1_ROT 8
#endif
#ifndef P1_ALIGN
#define P1_ALIGN true
#endif
#define PH1() do { { LAS float* gl = (LAS float*)(F.lds + GAINS_OFF); if (F.tid < 64) gl[F.tid] = F.q_norm[F.tid] * (0.125f * 1.4426950408889634f); else if (F.tid < 128) gl[F.tid] = F.k_norm[F.tid - 64]; __syncthreads(); } \
        pg8::EpiInProj E{F.P, F.out, (const pg8::f32x4*)F.ROPE}; \
        for (int u = blockIdx.x; u < INW / 64; u += F.G) pg8::gemm128_direct<DM, pg8::EpiInProj>(F.lds, F.XB + (size_t)MP * DM, F.Wt_in, MP / 256, u, E); \
        if (F.G > INW / 64) { if ((int)blockIdx.x >= INW / 64) p1_late_weights(F, (int)blockIdx.x - INW / 64, F.G - INW / 64); } else p1_late_weights(F, (int)blockIdx.x, F.G); \
        pg8::Gemm g{F.XB, F.Wt_in, MP, INW, DM}; pg8::StaticOrder S; S.init(MP, INW, F.G, (int)blockIdx.x, P1_ROT);     \
        pg8::gemm_phase<pg8::EpiInProj, pg8::StaticOrder, P1_ALIGN, true>(F.lds + RING_OFF, g, S, E); } while (0)
#define PH3() do { for (int u = F.vcu; u < 128; u += F.G) samp_ret_unit(F, u); \
        for (int u = F.vcu; u < 256; u += F.G) samp_attn_unit(F, u); \
        { RkvPre Rk; int u = blockIdx.x; if (u < 512) ret_kv_load(F, u, Rk); for (; u < 512; u += F.G) ret_kv_unit(F, u, (u + F.G < 512) ? u + F.G : -1, Rk); } \
        attn_phase<false>(F, 1024, 2048, 7, 2); } while (0)
#define PH5() do { for (int u = blockIdx.x; u < 512; u += F.G) ret_out_unit(F, u); } while (0)
#define PH6() do { pg8::EpiMerge E{F.MG, DM, (const unsigned char*)F.P + GATE_OFF, (size_t)INW * 2, MR}; \
        for (int u = blockIdx.x; u < 256; u += F.G) samp_micro_unit<true>(F, u); \
        pg8::Gemm g{F.GA, F.Wt_pr, MP, DM, 1536}; pg8::StaticOrder S; S.init(MP, DM, F.G, (int)blockIdx.x); \
        pg8::gemm_phase<pg8::EpiMerge, pg8::StaticOrder, true, true>(F.lds + RING_OFF, g, S, E); } while (0)
#define PH7() do { } while (0)
#define PH8() do { pg8::EpiResidual E{F.xp, F.xs, F.out, DM, MP, MR}; \
        for (int u = blockIdx.x; u < 256; u += F.G) samp_micro_unit<false>(F, u); \
        pg8::Gemm g{F.MG, F.Wt_out, MP, DM, DM}; pg8::StaticOrder S; S.init(MP, DM, F.G, (int)blockIdx.x); \
        pg8::gemm_phase<pg8::EpiResidual, pg8::StaticOrder, true, true>(F.lds + RING_OFF, g, S, E); } while (0)
#define PH6_8() do { PH6(); \
        pg8::f32x4 xacc[2][2][4][2]; \
        { pg8::EpiResidual E7{F.xp, F.xs, F.out, DM, MP, MR}; pg8::StaticOrder S7; S7.init(MP, DM, F.G, (int)blockIdx.x); pg8::Unit u7; S7.next(0, u7); \
          E7.init(xacc, u7, F.wave >> 2, F.wave & 3, F.lane & 15, F.lane >> 4); } \
        xcd_barrier(bar); \
        { pg8::EpiResidual E8{F.xp, F.xs, F.out, DM, MP, MR}; pg8::StaticOrder S8; S8.init(MP, DM, F.G, (int)blockIdx.x); pg8::Gemm g8{F.MG, F.Wt_out, MP, DM, DM}; \
          pg8::gemm_phase<pg8::EpiResidual, pg8::StaticOrder, true, true, true>(F.lds + RING_OFF, g8, S8, E8, xacc); \
          for (int u = blockIdx.x; u < 16; u += F.G) pg8::gemm128_direct<DM, pg8::EpiResidual>(F.lds, F.MG + (size_t)MP * DM, F.Wt_out, MP / 256, u, E8); } } while (0)
    if (IN(0)) { p0_prologue(F);
#if DBL == 11
        p0_prologue(F);
#endif
#if REP_PHASE == 0
        p0_prologue(F);
#endif
    } SEAM(0);
#if MK_N_LAUNCHES == 1 && REP_PHASE == -1
    if (IN(1)) {   LAS float* gl = (LAS float*)(F.lds + GAINS_OFF); if (F.tid < 64) gl[F.tid] = F.q_norm[F.tid] * (0.125f * 1.4426950408889634f); else if (F.tid < 128) gl[F.tid] = F.k_norm[F.tid - 64]; __syncthreads();
        pg8::EpiInProj E{F.P, F.out, (const pg8::f32x4*)F.ROPE};
        for (int u = blockIdx.x; u < INW / 64; u += F.G) pg8::gemm128_direct<DM, pg8::EpiInProj>(F.lds, F.XB + (size_t)MP * DM, F.Wt_in, MP / 256, u, E);
        if (F.G > INW / 64) { if ((int)blockIdx.x >= INW / 64) p1_late_weights(F, (int)blockIdx.x - INW / 64, F.G - INW / 64); } else p1_late_weights(F, (int)blockIdx.x, F.G);
#if DBL == 1
        for (int u = blockIdx.x; u < INW / 64; u += F.G) pg8::gemm128_direct<DM, pg8::EpiInProj>(F.lds, F.XB + (size_t)MP * DM, F.Wt_in, MP / 256, u, E);
#endif
        xcd_split_arrive(bar, 0);
        pg8::Gemm g{F.XB, F.Wt_in, MP, INW, DM}; pg8::StaticOrder S; S.init(MP, INW, F.G, (int)blockIdx.x, P1_ROT);
        pg8::gemm_phase<pg8::EpiInProj, pg8::StaticOrder, P1_ALIGN, true>(F.lds + RING_OFF, g, S, E); }
    if (IN(3)) {
    xcd_split_arrive(bar, 1);
    xcd_split_wait(bar, 0);
    for (int u = F.vcu; u < 256; u += F.G) samp_attn_unit(F, u);
#if DBL == 2
    for (int u = F.vcu; u < 256; u += F.G) samp_attn_unit(F, u);
#endif
    for (int u = F.vcu; u < 128; u += F.G) samp_ret_unit(F, u);
    xcd_split_wait(bar, 1);
    { RkvPre Rk; int u = blockIdx.x; if (u < 512) ret_kv_load(F, u, Rk); for (; u < 512; u += F.G) ret_kv_unit(F, u, (u + F.G < 512) ? u + F.G : -1, Rk); }
    xcd_split_arrive(bar, 2);
    attn_phase<false>(F, 1024, 2048, 7, 2);
#if DBL == 5
    attn_phase<false>(F, 1024, 2048, 7, 2);
#endif
    xcd_split_arrive(bar, 3);
    xcd_split_wait(bar, 2);
    p4_scan_combine(F); p4_samp_combine(F);
    xcd_split_arrive(bar, 4);
    xcd_split_wait(bar, 3);
    attn_phase<true>(F, 0, 1024, 4, 0);
#if DBL == 7
    attn_phase<true>(F, 0, 1024, 4, 0);
#endif
    xcd_split_wait(bar, 4);
    PH5();
#if DBL == 8
    PH5();
#endif
    }
    if (IN(6)) {
    xcd_split_arrive(bar, 5);
    for (int u = blockIdx.x; u < 256; u += F.G) samp_micro_unit<true>(F, u);
    xcd_split_arrive(bar, 6);
    xcd_split_wait(bar, 5);
    {   pg8::EpiMerge E{F.MG, DM, (const unsigned char*)F.P + GATE_OFF, (size_t)INW * 2, MR};
        pg8::Gemm g{F.GA, F.Wt_pr, MP, DM, 1536}; pg8::StaticOrder S; S.init(MP, DM, F.G, (int)blockIdx.x);
        pg8::gemm_phase<pg8::EpiMerge, pg8::StaticOrder, true, true>(F.lds + RING_OFF, g, S, E);
#if DBL == 13
        pg8::gemm_phase<pg8::EpiMerge, pg8::StaticOrder, true, true, false, true>(F.lds + RING_OFF, g, S, E);
#endif
        } }
    if (IN(8)) {
    xcd_split_arrive(bar, 7);
    xcd_split_wait(bar, 6);
    for (int u = blockIdx.x; u < 256; u += F.G) samp_micro_unit<false>(F, u);
    {   pg8::EpiResidual E{F.xp, F.xs, F.out, DM, MP, MR};
        pg8::Gemm g{F.MG, F.Wt_out, MP, DM, DM}; pg8::StaticOrder S; S.init(MP, DM, F.G, (int)blockIdx.x);
        pg8::f32x4 xacc[2][2][4][2];
        { pg8::Unit u0; if (S.next(0, u0)) E.init(xacc, u0, F.wave >> 2, F.wave & 3, F.lane & 15, F.lane >> 4); }
        xcd_split_wait(bar, 7);
        pg8::gemm_phase<pg8::EpiResidual, pg8::StaticOrder, true, true, true>(F.lds + RING_OFF, g, S, E, xacc);
#if DBL == 14
        pg8::gemm_phase<pg8::EpiResidual, pg8::StaticOrder, true, true, false, true>(F.lds + RING_OFF, g, S, E);
#endif
        } }
#else
    if (IN(1)) {
#if REP_PHASE == 15
        { pg8::EpiPlainLine EN{F.P, INW}; pg8::Gemm g{F.XB, F.Wt_in, MP, INW, DM}; pg8::StaticOrder S; S.init(MP, INW, F.G, (int)blockIdx.x);
          pg8::gemm_phase<pg8::EpiPlainLine, pg8::StaticOrder, true, true, false, true>(F.lds + RING_OFF, g, S, EN); }
#endif
#if REP_PHASE == 14
        { pg8::EpiPlainFull EN{F.P, INW}; pg8::Gemm g{F.XB, F.Wt_in, MP, INW, DM}; pg8::StaticOrder S; S.init(MP, INW, F.G, (int)blockIdx.x);
          pg8::gemm_phase<pg8::EpiPlainFull, pg8::StaticOrder, true, true>(F.lds + RING_OFF, g, S, EN); }
#endif
#if REP_PHASE == 13
        { pg8::EpiPlain EN{F.P, INW, MR}; pg8::Gemm g{F.XB, F.Wt_in, MP, INW, DM}; pg8::StaticOrder S; S.init(MP, INW, F.G, (int)blockIdx.x);
          pg8::gemm_phase<pg8::EpiPlain, pg8::StaticOrder, true, true, false, true>(F.lds + RING_OFF, g, S, EN); }
#endif
#if REP_PHASE == 12
        { pg8::EpiScratch EN{F.MG + (size_t)blockIdx.x * 65536}; pg8::Gemm g{F.XB, F.Wt_in, MP, INW, DM}; pg8::StaticOrder S; S.init(MP, INW, F.G, (int)blockIdx.x);
          pg8::gemm_phase<pg8::EpiScratch, pg8::StaticOrder, true, true>(F.lds + RING_OFF, g, S, EN); }
#endif
#if REP_PHASE == 11
        { pg8::EpiNull EN; pg8::Gemm g{F.XB, F.Wt_in, MP, INW, DM}; pg8::StaticOrder S; S.init(MP, INW, F.G, (int)blockIdx.x);
          pg8::gemm_phase<pg8::EpiNull, pg8::StaticOrder, true, true>(F.lds + RING_OFF, g, S, EN); }
#endif
        PH1();
#if REP_PHASE == 1
        PH1();
#endif
    } SEAM(1);
    if (IN(3)) { PH3();
#if REP_PHASE == 3
        PH3();
#endif
#if REP_PHASE == 31
        attn_phase<false>(F, 1024, 2048, 7, 2);
#endif
#if REP_PHASE == 32
        for (int u = blockIdx.x; u < 128; u += F.G) samp_ret_unit(F, u);
        for (int u = blockIdx.x; u < 256; u += F.G) samp_attn_unit(F, u);
#endif
#if REP_PHASE == 34
        for (int u = F.vcu; u < 256; u += F.G) samp_attn_unit(F, u);
#endif
#if REP_PHASE == 35
        for (int u = F.vcu; u < 128; u += F.G) samp_ret_unit(F, u);
#endif
#if REP_PHASE == 33
        { RkvPre Rk; int u = blockIdx.x; if (u < 512) ret_kv_load(F, u, Rk); for (; u < 512; u += F.G) ret_kv_unit(F, u, (u + F.G < 512) ? u + F.G : -1, Rk); }
#endif
    } SEAM(3);
    if (IN(4)) { p4_scan_combine(F); p4_samp_combine(F); attn_phase<true>(F, 0, 1024, 4, 0);
#if REP_PHASE == 4
        p4_scan_combine(F); attn_phase<true>(F, 0, 1024, 4, 0);
#endif
#if REP_PHASE == 41
        p4_scan_combine(F);
#endif
#if REP_PHASE == 42
        attn_phase<true>(F, 0, 1024, 4, 0);
#endif
#if REP_PHASE == 43
        attn_phase<false>(F, 0, 1024, 4, 0);
#endif
#if REP_PHASE == 44
        attn_phase<false>(F, 1024, 1024, 4, 0);
#endif
    } SEAM(4);
    if (IN(5)) { PH5();
#if REP_PHASE == 5
        PH5();
#endif
    } SEAM(5);
#if REP_PHASE == 6
    if (IN(6)) { PH6(); } SEAM(6);
    if (IN(8)) { PH8(); } xcd_barrier(bar);
    if (IN(6)) { PH6(); } SEAM(6);
    if (IN(8)) { PH8(); }
#elif REP_PHASE == 81
    if (IN(6)) { PH6(); } SEAM(6);
    if (IN(8)) { PH8(); PH8(); }
#elif REP_PHASE == 63
    if (IN(6)) { { pg8::EpiMerge E{F.MG, DM, (const unsigned char*)F.P + GATE_OFF, (size_t)INW * 2, MR};
        for (int u = blockIdx.x; u < 32; u += F.G) pg8::gemm128_half<1536, 1024, pg8::EpiMerge>(F.lds, F.GA + (size_t)MP * 1536, 1536, F.Wt_pr, 1536, MP / 256, u, E); }
        PH6(); } SEAM(6);
    if (IN(8)) { { pg8::EpiResidual E{F.xp, F.xs, F.out, DM, MP, MR};
        for (int u = blockIdx.x; u < 32; u += F.G) pg8::gemm128_half<DM, 0, pg8::EpiResidual>(F.lds, F.MG + (size_t)MP * DM, DM, F.Wt_out, DM, MP / 256, u, E); }
        PH8(); }
#else
    if (IN(6)) { PH6(); } SEAM(6);
    if (IN(8)) { PH8(); }
#endif
#endif
#undef IN
#undef SEAM
}

extern "C" void kernel_launch(void* const* d_in, const int* in_sizes, int n_in, void* d_out, int out_size, void* d_ws, size_t ws_size, hipStream_t stream) {
    static int grid = 0;
    if (grid == 0) {
        if (n_in != 15 || (size_t)out_size != O_END || ws_size < WS_END) { fprintf(stderr, "kernel_launch: unexpected shapes: n_in %d out %d ws %zu\n", n_in, out_size, ws_size); grid = -1; return; }
        int dev = 0, cus = 0;
        if (hipGetDevice(&dev) != hipSuccess || hipDeviceGetAttribute(&cus, hipDeviceAttributeMultiprocessorCount, dev) != hipSuccess) { grid = -1; return; }
        if (hipFuncSetAttribute((const void*)mk_fwd, hipFuncAttributeMaxDynamicSharedMemorySize, LDS_BYTES) != hipSuccess) { fprintf(stderr, "kernel_launch: hipFuncSetAttribute failed\n"); grid = -1; return; }
        int per_cu = 0;
        if (hipOccupancyMaxActiveBlocksPerMultiprocessor(&per_cu, (const void*)mk_fwd, NWAVES * 64, LDS_BYTES) != hipSuccess || per_cu < 1) fprintf(stderr, "kernel_launch: occupancy query says %d per CU\n", per_cu);
        (void)hipGetLastError();
        grid = cus;
    }
    if (grid < 0) return;
    if (hipMemsetAsync((char*)d_ws + WS_CTL, 0, CTL_ZERO_BYTES, stream) != hipSuccess) return;
    Args a{};
    for (int i = 0; i < 15; ++i) a.in[i] = (const float*)d_in[i];
    a.out = (float*)d_out; a.ws = (unsigned char*)d_ws;
    if (MK_N_LAUNCHES == 1) { a.ph_lo = 0; a.ph_hi = N_PHASES; a.use_bar = 1; hipLaunchKernelGGL(mk_fwd, dim3(grid), dim3(NWAVES * 64), LDS_BYTES, stream, a); }
    else { for (int p = 0; p < N_PHASES; ++p) { a.ph_lo = p; a.ph_hi = p + 1; a.use_bar = 0; hipLaunchKernelGGL(mk_fwd, dim3(grid), dim3(NWAVES * 64), LDS_BYTES, stream, a); } }
}
```
